# Optimizing an MI355X kernel written in HIP

```python
import math
import jax, jax.numpy as jnp
from jax import lax
import numpy as np

D_MODEL = 1024
BATCH = 32
SEQ = 2048
DEPTH = 4

N_MEM = 256
HEAD_DIM = 64
SWA_HEADS = 8
SWA_KV_HEADS = 2
SWA_GROUP = SWA_HEADS // SWA_KV_HEADS
WINDOW = 128
SB_HEADS = 8
SB_BLOCK = 128
HGRN_HEAD_DIM = 128
HGRN_HEADS = D_MODEL // HGRN_HEAD_DIM
HGRN_CHUNK = 32
XA_HEADS = 4
XA_HEAD_DIM = D_MODEL // XA_HEADS
D_FF = 128 * ((8 * D_MODEL // 3 + 127) // 128)
CONV_WIDTH = 3
ROPE_THETA = 10000.0
EPS = 1e-6
N_EVEN = (DEPTH + 1) // 2
N_ODD = DEPTH // 2
SWA_Q_W = SWA_HEADS * HEAD_DIM
SWA_KV_W = SWA_KV_HEADS * HEAD_DIM
SB_W = SB_HEADS * HEAD_DIM
AB_IN = SWA_Q_W + 2 * SWA_KV_W + 3 * SB_W
AB_OUT = SWA_Q_W + SB_W

kernel_name = "hybrid_swa_stickbreak_hgrn2_trunk"


def rms_norm(x, gain):
    x32 = x.astype(jnp.float32)
    y = x32 * lax.rsqrt(jnp.mean(x32 * x32, axis=-1, keepdims=True) + EPS)
    return (y * gain.astype(jnp.float32)).astype(x.dtype)


def rope(x, positions):
    d = x.shape[-1]
    inv_freq = ROPE_THETA ** (-jnp.arange(0, d, 2, dtype=jnp.float32) / d)
    ang = positions.astype(jnp.float32)[..., None] * inv_freq
    cos, sin = jnp.cos(ang)[:, :, None, :], jnp.sin(ang)[:, :, None, :]
    x1, x2 = x[..., : d // 2], x[..., d // 2:]
    return jnp.concatenate([x1 * cos - x2 * sin, x2 * cos + x1 * sin], axis=-1)


def sliding_window_attention(q, k, v, sinks):
    B, S = q.shape[:2]
    nb = S // WINDOW
    qb = q.reshape(B, nb, WINDOW, SWA_KV_HEADS, SWA_GROUP, HEAD_DIM)

    def band(t):
        prev = jnp.pad(t, ((0, 0), (WINDOW, 0), (0, 0), (0, 0)))[:, :S]
        return jnp.concatenate([prev.reshape(B, nb, WINDOW, SWA_KV_HEADS, HEAD_DIM),
                                t.reshape(B, nb, WINDOW, SWA_KV_HEADS, HEAD_DIM)], axis=2)

    kb, vb = band(k), band(v)
    s = jnp.einsum('bnqhgd,bnkhd->bnhgqk', qb, kb) * (HEAD_DIM ** -0.5)
    i = jnp.arange(WINDOW)[:, None]
    j = jnp.arange(2 * WINDOW)[None, :]
    blk = jnp.arange(nb)[:, None, None]
    mask = (j > i) & (j <= i + WINDOW) & (blk * WINDOW - WINDOW + j >= 0)
    s = jnp.where(mask[None, :, None, None], s, -jnp.inf)
    sink = sinks.astype(jnp.float32).reshape(SWA_KV_HEADS, SWA_GROUP)[None, None, :, :, None, None]
    m = jnp.maximum(jnp.max(s, axis=-1, keepdims=True), sink)
    p = jnp.exp(s - m)
    p = p / (jnp.sum(p, axis=-1, keepdims=True) + jnp.exp(sink - m))
    o = jnp.einsum('bnhgqk,bnkhd->bnqhgd', p, vb)
    return o.reshape(B, S, SWA_Q_W)


def stick_breaking_attention(q, k, v):
    B, S = q.shape[:2]
    outs = []
    for n in range(S // SB_BLOCK):
        t0, t1 = n * SB_BLOCK, (n + 1) * SB_BLOCK
        z = jnp.einsum('bqhd,bkhd->bhqk', q[:, t0:t1], k[:, :t1]) * (HEAD_DIM ** -0.5)
        causal = jnp.arange(t1)[None, :] < (t0 + jnp.arange(SB_BLOCK))[:, None]
        log_fail = jnp.where(causal, -jax.nn.softplus(z), 0.0)
        log_after = lax.cumsum(log_fail, axis=3, reverse=True) - log_fail
        a = jnp.where(causal, jnp.exp(jax.nn.log_sigmoid(z) + log_after), 0.0)
        outs.append(jnp.einsum('bhqk,bkhd->bqhd', a, v[:, :t1]))
    return jnp.concatenate(outs, axis=1).reshape(B, S, SB_W)


def hgrn2_chunkwise(q, k, v, log_f):
    B, S, H, dk = q.shape
    dv = v.shape[-1]
    nc = S // HGRN_CHUNK

    def chunks(t):
        return t.reshape(B, nc, HGRN_CHUNK, H, t.shape[-1]).transpose(1, 0, 3, 2, 4)

    qc, kc, vc = chunks(q), chunks(k), chunks(v)
    bc = jnp.cumsum(chunks(log_f), axis=3)
    tril = jnp.tril(jnp.ones((HGRN_CHUNK, HGRN_CHUNK), dtype=bool))

    def step(state, inp):
        qi, ki, vi, bi = inp
        b_last = bi[:, :, -1:, :]
        rel = jnp.where(tril[None, None, :, :, None],
                        bi[:, :, :, None, :] - bi[:, :, None, :, :], -jnp.inf)
        scores = jnp.einsum('bhtd,bhsd,bhtsd->bhts', qi, ki, jnp.exp(rel))
        o = (jnp.einsum('bhts,bhse->bhte', scores, vi)
             + jnp.einsum('bhtd,bhde->bhte', qi * jnp.exp(bi), state))
        state = (jnp.exp(b_last)[:, :, 0, :, None] * state
                 + jnp.einsum('bhsd,bhse->bhde', ki * jnp.exp(b_last - bi), vi))
        return state, o

    s0 = jnp.zeros((B, H, dk, dv), jnp.float32)
    _, o = lax.scan(step, s0, (qc, kc, vc, bc))
    return o.transpose(1, 0, 3, 2, 4).reshape(B, S, H, dv)


def swa_sb_mixer(h, positions, w_in, w_out, q_norm, k_norm, sinks):
    B, S, _ = h.shape
    f32 = jnp.float32
    cuts = (SWA_Q_W, SWA_Q_W + SWA_KV_W, SWA_Q_W + 2 * SWA_KV_W,
            SWA_Q_W + 2 * SWA_KV_W + SB_W, SWA_Q_W + 2 * SWA_KV_W + 2 * SB_W)
    qa, ka, va, qb, kb, vb = jnp.split((h @ w_in).astype(f32), cuts, axis=-1)
    qa = rope(rms_norm(qa.reshape(B, S, SWA_HEADS, HEAD_DIM), q_norm), positions)
    ka = rope(rms_norm(ka.reshape(B, S, SWA_KV_HEADS, HEAD_DIM), k_norm), positions)
    va = va.reshape(B, S, SWA_KV_HEADS, HEAD_DIM)
    out_a = sliding_window_attention(qa, ka, va, sinks)
    heads_b = lambda t: t.reshape(B, S, SB_HEADS, HEAD_DIM)
    out_b = stick_breaking_attention(heads_b(qb), heads_b(kb), heads_b(vb))
    return jnp.concatenate([out_a, out_b], axis=-1).astype(h.dtype) @ w_out


def hgrn2_mixer(h, w_in, w_out, o_norm, lower_bound):
    B, S, _ = h.shape
    f32 = jnp.float32
    q, f_logit, i_in, g = jnp.split((h @ w_in).astype(f32), 4, axis=-1)
    lb = lower_bound.astype(f32)
    log_f = jnp.log(lb + (1.0 - lb) * jax.nn.sigmoid(f_logit))
    k = (1.0 - lb) * jax.nn.sigmoid(-f_logit)
    heads = lambda t: t.reshape(B, S, HGRN_HEADS, HGRN_HEAD_DIM)
    o = hgrn2_chunkwise(heads(q), heads(k), heads(i_in), heads(log_f))
    o = rms_norm(o, o_norm) * jax.nn.silu(heads(g))
    return o.reshape(B, S, HGRN_HEADS * HGRN_HEAD_DIM).astype(h.dtype) @ w_out


def memory_cross_attention(h, mem_n, w_q, w_kv, w_o, q_norm, k_norm):
    B, S, _ = h.shape
    M = mem_n.shape[1]
    f32 = jnp.float32
    q = rms_norm((h @ w_q).astype(f32).reshape(B, S, XA_HEADS, XA_HEAD_DIM), q_norm)
    kv = (mem_n @ w_kv).astype(f32).reshape(B, M, 2, XA_HEADS, XA_HEAD_DIM)
    k = rms_norm(kv[:, :, 0], k_norm)
    v = kv[:, :, 1]
    s = jnp.einsum('bshd,bmhd->bhsm', q, k) * (XA_HEAD_DIM ** -0.5)
    p = jax.nn.softmax(s, axis=-1)
    o = jnp.einsum('bhsm,bmhd->bshd', p, v).reshape(B, S, D_MODEL)
    return o.astype(h.dtype) @ w_o


def conv_ffn(h, w_up, conv_w, conv_b, w_down):
    S = h.shape[1]
    u = h @ w_up
    shift = lambda t, n: jnp.pad(t, ((0, 0), (n, 0), (0, 0)))[:, :S]
    u = sum(conv_w[CONV_WIDTH - 1 - n] * shift(u, n) for n in range(CONV_WIDTH)) + conv_b
    gate, up = jnp.split(u, 2, axis=-1)
    return (jax.nn.silu(gate) * up) @ w_down


def setup_inputs(seed: int = 0) -> dict:
    key = jax.random.key(seed)
    ks = jax.random.split(key, 24)
    f32 = jnp.float32

    def dense(k, shape):
        return jax.random.normal(k, shape, f32) * (shape[-2] ** -0.5)

    def gain(k, shape):
        return 1.0 + 0.02 * jax.random.normal(k, shape, f32)

    x = jax.random.normal(ks[0], (BATCH, SEQ, D_MODEL), f32)
    mem = jax.random.normal(ks[1], (BATCH, N_MEM, D_MODEL), f32)
    positions = (jax.random.randint(ks[2], (BATCH, 1), 0, 1024, dtype=jnp.int32)
                 + jnp.arange(SEQ, dtype=jnp.int32)[None, :])
    return {
        "x": x,
        "mem": mem,
        "positions": positions,
        "norm_mix": gain(ks[3], (DEPTH, D_MODEL)),
        "norm_cross": gain(ks[4], (DEPTH, D_MODEL)),
        "norm_mem": gain(ks[5], (DEPTH, D_MODEL)),
        "norm_ffn": gain(ks[6], (DEPTH, D_MODEL)),
        "ab_w_in": dense(ks[7], (N_EVEN, D_MODEL, AB_IN)),
        "ab_w_out": dense(ks[8], (N_EVEN, AB_OUT, D_MODEL)),
        "swa_q_norm": gain(ks[9], (N_EVEN, HEAD_DIM)),
        "swa_k_norm": gain(ks[10], (N_EVEN, HEAD_DIM)),
        "swa_sinks": 0.5 * jax.random.normal(ks[11], (N_EVEN, SWA_HEADS), f32),
        "hgrn_w_in": dense(ks[12], (N_ODD, D_MODEL, 4 * HGRN_HEADS * HGRN_HEAD_DIM)),
        "hgrn_w_out": dense(ks[13], (N_ODD, HGRN_HEADS * HGRN_HEAD_DIM, D_MODEL)),
        "hgrn_o_norm": gain(ks[14], (N_ODD, HGRN_HEAD_DIM)),
        "hgrn_lb": jax.random.normal(ks[15], (DEPTH, HGRN_HEADS * HGRN_HEAD_DIM), f32),
        "xa_w_q": dense(ks[16], (DEPTH, D_MODEL, D_MODEL)),
        "xa_w_kv": dense(ks[17], (DEPTH, D_MODEL, 2 * D_MODEL)),
        "xa_w_o": dense(ks[18], (DEPTH, D_MODEL, D_MODEL)),
        "xa_q_norm": gain(ks[19], (DEPTH, XA_HEAD_DIM)),
        "xa_k_norm": gain(ks[20], (DEPTH, XA_HEAD_DIM)),
        "ffn_w_up": dense(ks[21], (DEPTH, D_MODEL, 2 * D_FF)),
        "ffn_conv_w": jax.random.normal(ks[22], (DEPTH, CONV_WIDTH, 2 * D_FF), f32) * (CONV_WIDTH ** -0.5),
        "ffn_conv_b": 0.02 * jax.random.normal(jax.random.fold_in(ks[22], 1), (DEPTH, 2 * D_FF), f32),
        "ffn_w_down": dense(ks[23], (DEPTH, D_FF, D_MODEL)),
    }


def reference(x, mem, positions, norm_mix, norm_cross, norm_mem, norm_ffn,
              ab_w_in, ab_w_out, swa_q_norm, swa_k_norm, swa_sinks,
              hgrn_w_in, hgrn_w_out, hgrn_o_norm, hgrn_lb,
              xa_w_q, xa_w_kv, xa_w_o, xa_q_norm, xa_k_norm,
              ffn_w_up, ffn_conv_w, ffn_conv_b, ffn_w_down):
    p_lb = jax.nn.softmax(hgrn_lb.astype(jnp.float32), axis=0)
    lower_bounds = jnp.cumsum(p_lb, axis=0) - p_lb[0]
    for l in range(DEPTH):
        h = rms_norm(x, norm_mix[l])
        if l % 2 == 0:
            e = l // 2
            x = x + swa_sb_mixer(h, positions, ab_w_in[e], ab_w_out[e],
                                 swa_q_norm[e], swa_k_norm[e], swa_sinks[e])
        else:
            o = l // 2
            x = x + hgrn2_mixer(h, hgrn_w_in[o], hgrn_w_out[o], hgrn_o_norm[o], lower_bounds[l])
        mem_n = rms_norm(mem, norm_mem[l])
        x = x + memory_cross_attention(rms_norm(x, norm_cross[l]), mem_n, xa_w_q[l], xa_w_kv[l],
                                       xa_w_o[l], xa_q_norm[l], xa_k_norm[l])
        x = x + conv_ffn(rms_norm(x, norm_ffn[l]), ffn_w_up[l], ffn_conv_w[l], ffn_conv_b[l], ffn_w_down[l])
    return x
```

```cpp
#include <hip/hip_runtime.h>
#include <cstdio>
#include <cstdint>
#include <cmath>
namespace pg8 {
#define PG8_LAS __attribute__((address_space(3)))
typedef unsigned short bf16_t;
typedef short bf16x8 __attribute__((ext_vector_type(8)));
typedef float f32x4 __attribute__((ext_vector_type(4)));
typedef unsigned u32x4 __attribute__((ext_vector_type(4)));
constexpr int BM = 256, BK = 64, HALF = 128, HTB = HALF * BK * 2  , STAGE_BYTES = 8 * HTB, NXCD = 8, WGM = 8;

__host__ __device__ __forceinline__ int lds_byte(int r, int c) { const int st = (r >> 4) * 2 + (c >> 5), rr = r & 15, cc = c & 31, ob = rr * 64 + cc * 2; return st * 1024 + (ob ^ (((ob >> 9) & 1) << 5)); }
__host__ __device__ __forceinline__ void stage_rc(int b, int& R, int& C) { const int st = b / 1024, sb = b % 1024, swz = sb ^ (((sb >> 9) & 1) << 5); R = (st >> 1) * 16 + swz / 64; C = (st & 1) * 32 + (swz % 64) / 2; }
__host__ __device__ __forceinline__ int perm32(int rho) { const int n = rho >> 4, i = rho & 15; return 8 * (i >> 2) + 4 * n + (i & 3); }

struct Unit { int pm, pn; };
struct Gemm { const bf16_t* A; const bf16_t* Bt; int M, N, K; };

struct StaticOrder {
    int nM, nN, nwg, G, c;
    __host__ __device__ __forceinline__ void init(int M, int N, int G_, int c_) { nM = M / BM; nN = N / BM; nwg = nM * nN; G = G_; c = c_; }
    __host__ __device__ __forceinline__ bool next(int i, Unit& u) const {
        const long L = (long)i * G + c; if (L >= nwg) return false;
        int wgid = (int)L; { const int q = nwg / NXCD, r = nwg % NXCD, xcd = wgid % NXCD, off = wgid / NXCD; wgid = (xcd < r ? xcd * (q + 1) : r * (q + 1) + (xcd - r) * q) + off; }
        const int nig = WGM * nN, gid = wgid / nig, fm = gid * WGM, gsz = (nM - fm) < WGM ? (nM - fm) : WGM;
        u.pm = fm + ((wgid % nig) % gsz); u.pn = (wgid % nig) / gsz; return true;
    }
    __device__ __forceinline__ void a_ready(const Unit&) const {}
    __device__ __forceinline__ void done(const Unit&) const {}
};

__device__ __forceinline__ unsigned cvt_pk_bf16(float lo, float hi) { unsigned r; asm volatile("v_cvt_pk_bf16_f32 %0, %1, %2" : "=v"(r) : "v"(lo), "v"(hi)); return r; }
typedef float f32x2 __attribute__((ext_vector_type(2)));

__device__ __forceinline__ void unit_rstd(PG8_LAS float* rs, const float* rowsq, int pm) {
    int t = threadIdx.x; asm volatile("" : "+v"(t));
    if (t < 256) { const f32x4* rp = (const f32x4*)(rowsq + (size_t)(pm * BM + t) * 16); const f32x4 a = rp[0], b = rp[1], c = rp[2], d = rp[3];
        const float s = ((a[0] + a[1]) + (a[2] + a[3])) + ((b[0] + b[1]) + (b[2] + b[3])) + ((c[0] + c[1]) + (c[2] + c[3])) + ((d[0] + d[1]) + (d[2] + d[3]));
        rs[t] = 1.0f / sqrtf(s * (1.0f / 1024.0f) + 1e-6f); }
    asm volatile("s_waitcnt lgkmcnt(0)\n\ts_barrier" ::: "memory");
}

__device__ __forceinline__ void unit_rstd_conv(PG8_LAS float* rs, const float* rowsq, int pm, PG8_LAS float* ct, const float* cw, const float* cb, int pn) {
    int t = threadIdx.x; asm volatile("" : "+v"(t));
    if (t < 256) { const f32x4* rp = (const f32x4*)(rowsq + (size_t)(pm * BM + t) * 16); const f32x4 a = rp[0], b = rp[1], c = rp[2], d = rp[3];
        const float s = ((a[0] + a[1]) + (a[2] + a[3])) + ((b[0] + b[1]) + (b[2] + b[3])) + ((c[0] + c[1]) + (c[2] + c[3])) + ((d[0] + d[1]) + (d[2] + d[3]));
        rs[t] = 1.0f / sqrtf(s * (1.0f / 1024.0f) + 1e-6f); }
    else { const int j = t - 256, p = j >> 5, c4 = (j & 31) * 4; const float* srcp = ((p & 3) < 3 ? cw + (p & 3) * 5632 : cb) + (p >> 2) * 2816 + pn * 128 + c4;
        const float k = (p >> 2) ? 0.6931471805599453f : 1.4426950408889634f;
        *(PG8_LAS f32x4*)(ct + p * 128 + c4) = *(const f32x4*)srcp * k; }
    asm volatile("s_waitcnt lgkmcnt(0)\n\ts_barrier" ::: "memory");
}

struct EpiScaleBf16 {
    static constexpr bool PERM = true, AFTER_DRAIN = false;
    bf16_t* O; int ldc; const float* rowsq; PG8_LAS float* rs;
    bf16_t* HM; int hm_pn0; size_t hm_stride;
    __device__ __forceinline__ void operator()(const f32x4 (&acc)[2][2][4][2], const Unit& u, int wr, int wc, int fr, int fq) const {
        if (rowsq) unit_rstd(rs, rowsq, u.pm);
        const bool hm = HM != nullptr && u.pn >= hm_pn0; const int q = u.pn - hm_pn0;
        const unsigned vo = 2u * (hm ? (unsigned)((((wc >> 1) * 2048 + wr * 64 + fr) * 64) + 32 * (wc & 1) + 8 * fq) : (unsigned)((wr * 64 + fr) * ldc + wc * 32 + 8 * fq));
#pragma unroll
        for (int ai = 0; ai < 2; ++ai)
#pragma unroll
            for (int m = 0; m < 4; ++m) { float sc = 1.f;
                if (rowsq) sc = rs[wr * 64 + fr + ai * HALF + m * 16];
#pragma unroll
                for (int bj = 0; bj < 2; ++bj) { const f32x4 v0 = acc[ai][bj][m][0] * sc, v1 = acc[ai][bj][m][1] * sc;
                    u32x4 w; w.x = cvt_pk_bf16(v0[0], v0[1]); w.y = cvt_pk_bf16(v0[2], v0[3]); w.z = cvt_pk_bf16(v1[0], v1[1]); w.w = cvt_pk_bf16(v1[2], v1[3]);
                    const bf16_t* ob = O + (size_t)(u.pm * BM + ai * HALF + m * 16) * ldc + u.pn * BM + bj * HALF;
                    const bf16_t* hb = HM + (size_t)(q >> 1) * hm_stride + (size_t)((((u.pm >> 3) * 8 + (q & 1) * 4 + 2 * bj) * 2048) + (u.pm & 7) * 256 + ai * HALF + m * 16) * 64;
                    *(u32x4*)((char*)(hm ? hb : ob) + vo) = w; } }
    }
};
struct EpiKV {
    static constexpr bool PERM = true, AFTER_DRAIN = false;
    bf16_t* O; int ldc; const float* gq; const float* gk; PG8_LAS float* rs;
    __device__ __forceinline__ void operator()(const f32x4 (&acc)[2][2][4][2], const Unit& u, int wr, int wc, int fr, int fq) const {
        const int row0 = u.pm * BM + wr * 64 + fr; const int col0 = u.pn * BM + wc * 32 + 8 * fq; const bool isk = u.pn < 4;
        float sc[2][4]; f32x4 g[2][2];
#pragma unroll
        for (int ai = 0; ai < 2; ++ai)
#pragma unroll
            for (int m = 0; m < 4; ++m) sc[ai][m] = 1.f;
#pragma unroll
        for (int bj = 0; bj < 2; ++bj)
#pragma unroll
            for (int n = 0; n < 2; ++n) g[bj][n] = (f32x4){1.f, 1.f, 1.f, 1.f};
        if (isk) { PG8_LAS float* part = rs + 256;
#pragma unroll
            for (int ai = 0; ai < 2; ++ai)
#pragma unroll
                for (int m = 0; m < 4; ++m) { float s = 0.f;
#pragma unroll
                    for (int bj = 0; bj < 2; ++bj)
#pragma unroll
                        for (int n = 0; n < 2; ++n)
#pragma unroll
                            for (int i = 0; i < 4; ++i) s = __builtin_fmaf(acc[ai][bj][m][n][i], acc[ai][bj][m][n][i], s);
                    s += __shfl_xor(s, 16); s += __shfl_xor(s, 32);
                    if (fq == 0) part[wc * 256 + wr * 64 + fr + ai * HALF + m * 16] = s; }
            asm volatile("s_waitcnt lgkmcnt(0)\n\ts_barrier" ::: "memory");
            { int t = threadIdx.x; asm volatile("" : "+v"(t));
              if (t < 256) rs[t] = 1.0f / sqrtf(((part[t] + part[256 + t]) + (part[512 + t] + part[768 + t])) * (1.0f / 256.0f) + 1e-6f); }
            asm volatile("s_waitcnt lgkmcnt(0)\n\ts_barrier" ::: "memory");
#pragma unroll
            for (int ai = 0; ai < 2; ++ai)
#pragma unroll
                for (int m = 0; m < 4; ++m) sc[ai][m] = rs[wr * 64 + fr + ai * HALF + m * 16];
#pragma unroll
            for (int bj = 0; bj < 2; ++bj)
#pragma unroll
                for (int n = 0; n < 2; ++n) { const int c = bj * HALF + wc * 32 + 8 * fq + 4 * n; g[bj][n] = *(const f32x4*)(gq + c) * *(const f32x4*)(gk + c); } }
#pragma unroll
        for (int ai = 0; ai < 2; ++ai)
#pragma unroll
            for (int m = 0; m < 4; ++m) { const int row = row0 + ai * HALF + m * 16; bf16_t* rowp = O + (size_t)row * ldc + col0;
#pragma unroll
                for (int bj = 0; bj < 2; ++bj) { const f32x4 v0 = acc[ai][bj][m][0] * g[bj][0] * sc[ai][m], v1 = acc[ai][bj][m][1] * g[bj][1] * sc[ai][m];
                    u32x4 w; w.x = cvt_pk_bf16(v0[0], v0[1]); w.y = cvt_pk_bf16(v0[2], v0[3]); w.z = cvt_pk_bf16(v1[0], v1[1]); w.w = cvt_pk_bf16(v1[2], v1[3]);
                    *(u32x4*)(rowp + bj * HALF) = w; } }
    }
};
struct EpiRes {
    static constexpr bool PERM = true, AFTER_DRAIN = false;
    float* out; bf16_t* xb; float* rowsq; bool fin; bf16_t* xbw;
    __device__ __forceinline__ void operator()(const f32x4 (&acc)[2][2][4][2], const Unit& u, int wr, int wc, int fr, int fq) const {
        const unsigned lv = (unsigned)((wr * 64 + fr) * 1024 + wc * 32 + 8 * fq);
#define UB(ai_, m_, bj_) ((size_t)(u.pm * BM + (ai_) * HALF + (m_) * 16) * 1024 + u.pn * BM + (bj_) * HALF)
        u32x4 xv[2][4][2];
#pragma unroll
        for (int ai = 0; ai < 2; ++ai)
#pragma unroll
            for (int m = 0; m < 4; ++m)
#pragma unroll
                for (int bj = 0; bj < 2; ++bj) xv[ai][m][bj] = *(const u32x4*)((const char*)(xb + UB(ai, m, bj)) + 2u * lv);
#pragma unroll
        for (int ai = 0; ai < 2; ++ai)
#pragma unroll
            for (int m = 0; m < 4; ++m) { float s = 0.f;
#pragma unroll
                for (int bj = 0; bj < 2; ++bj) { const u32x4 b = xv[ai][m][bj];
                    f32x4 o0 = acc[ai][bj][m][0], o1 = acc[ai][bj][m][1];
                    o0[0] += __uint_as_float(b.x << 16); o0[1] += __uint_as_float(b.x & 0xffff0000u); o0[2] += __uint_as_float(b.y << 16); o0[3] += __uint_as_float(b.y & 0xffff0000u);
                    o1[0] += __uint_as_float(b.z << 16); o1[1] += __uint_as_float(b.z & 0xffff0000u); o1[2] += __uint_as_float(b.w << 16); o1[3] += __uint_as_float(b.w & 0xffff0000u);
                    if (fin) { char* op_ = (char*)(out + UB(ai, m, bj)) + 4u * lv; *(f32x4*)op_ = o0; *(f32x4*)(op_ + 16) = o1; }
                    else { u32x4 w; w.x = cvt_pk_bf16(o0[0], o0[1]); w.y = cvt_pk_bf16(o0[2], o0[3]); w.z = cvt_pk_bf16(o1[0], o1[1]); w.w = cvt_pk_bf16(o1[2], o1[3]); *(u32x4*)((char*)(xbw + UB(ai, m, bj)) + 2u * lv) = w; }
#pragma unroll
                    for (int i = 0; i < 4; ++i) s = __builtin_fmaf(o0[i], o0[i], s);
#pragma unroll
                    for (int i = 0; i < 4; ++i) s = __builtin_fmaf(o1[i], o1[i], s); }
                s += __shfl_xor(s, 16); s += __shfl_xor(s, 32);
                if (fq == 0) *(float*)((char*)(rowsq + (size_t)(u.pm * BM + ai * HALF + m * 16) * 16 + u.pn * 4) + 4u * (unsigned)((wr * 64 + fr) * 16 + wc)) = s; }
    }
#undef UB
};

struct EpiConvGlu {
    static constexpr bool PERM = true, AFTER_DRAIN = false;
    bf16_t* ACT; const float* rowsq; const float* cw; const float* cb; float* EDGE; PG8_LAS float* rs;
    static __device__ __forceinline__ f32x4 shr1(const f32x4 v) { float r0, r1, r2, r3;
        asm volatile("s_nop 4\n\tv_mov_b32_dpp %0, %4 row_shr:1 row_mask:0xf bank_mask:0xf bound_ctrl:1\n\tv_mov_b32_dpp %1, %5 row_shr:1 row_mask:0xf bank_mask:0xf bound_ctrl:1\n\t"
                     "v_mov_b32_dpp %2, %6 row_shr:1 row_mask:0xf bank_mask:0xf bound_ctrl:1\n\tv_mov_b32_dpp %3, %7 row_shr:1 row_mask:0xf bank_mask:0xf bound_ctrl:1"
                     : "=&v"(r0), "=&v"(r1), "=&v"(r2), "=&v"(r3) : "v"(v[0]), "v"(v[1]), "v"(v[2]), "v"(v[3]));
        return (f32x4){r0, r1, r2, r3}; }
    __device__ __forceinline__ void operator()(f32x4 (&acc)[2][2][4][2], const Unit& u, int wr, int wc, int fr, int fq) const {
        const unsigned alv = (unsigned)(8 * (fr + 16 * wr) * 2816 + wc * 32 + 8 * fq);
        PG8_LAS float* ct = rs + 256; unit_rstd_conv(rs, rowsq, u.pm, ct, cw, cb, u.pn); const int cl = wc * 32 + 8 * fq;
        const f32x4 sc0 = *(const PG8_LAS f32x4*)(rs + 8 * (fr + 16 * wr)), sc1 = *(const PG8_LAS f32x4*)(rs + 8 * (fr + 16 * wr) + 4);
#pragma unroll
        for (int ai = 0; ai < 2; ++ai)
#pragma unroll
            for (int m = 0; m < 4; ++m) { const float sc = ai ? sc1[m] : sc0[m];
#pragma unroll
                for (int bj = 0; bj < 2; ++bj)
#pragma unroll
                    for (int n = 0; n < 2; ++n) acc[ai][bj][m][n] = acc[ai][bj][m][n] * sc; }
        { const unsigned elv = 4u * (unsigned)(wr * 4 * 5632 + wc * 32 + 8 * fq); float* const eu = EDGE + (size_t)(2 * u.pm) * 4 * 5632 + u.pn * BM;
#define ep_at(o_) ((char*)(eu + (o_)) + elv)
          if (fr == 0) {
#pragma unroll
              for (int bj = 0; bj < 2; ++bj)
#pragma unroll
                  for (int n = 0; n < 2; ++n) { *(f32x4*)ep_at(bj * HALF + 4 * n) = acc[0][bj][0][n]; *(f32x4*)ep_at(5632 + bj * HALF + 4 * n) = acc[0][bj][1][n]; }
              asm volatile("; strip-head rows stored" ::: "memory"); }
          if (fr == 15) {
#pragma unroll
              for (int bj = 0; bj < 2; ++bj)
#pragma unroll
                  for (int n = 0; n < 2; ++n) { *(f32x4*)ep_at(2 * 5632 + bj * HALF + 4 * n) = acc[1][bj][2][n]; *(f32x4*)ep_at(3 * 5632 + bj * HALF + 4 * n) = acc[1][bj][3][n]; }
              asm volatile("; strip-tail rows stored" ::: "memory"); } }
#undef ep_at
#pragma unroll
        for (int n = 0; n < 2; ++n) { asm volatile("" ::: "memory");
            const PG8_LAS float* cp = ct + cl + 4 * n;
            const f32x4 g0 = *(const PG8_LAS f32x4*)(cp), g1 = *(const PG8_LAS f32x4*)(cp + 128), g2 = *(const PG8_LAS f32x4*)(cp + 256), gb = *(const PG8_LAS f32x4*)(cp + 384);
            const f32x4 u0 = *(const PG8_LAS f32x4*)(cp + 512), u1 = *(const PG8_LAS f32x4*)(cp + 640), u2 = *(const PG8_LAS f32x4*)(cp + 768), ub = *(const PG8_LAS f32x4*)(cp + 896);
            const f32x4 gh1 = shr1(acc[1][0][3][n]), gh2 = shr1(acc[1][0][2][n]), uh1 = shr1(acc[1][1][3][n]), uh2 = shr1(acc[1][1][2][n]);
#pragma unroll
            for (int k = 0; k < 8; ++k) { const f32x4 gv = acc[k >> 2][0][k & 3][n], uv = acc[k >> 2][1][k & 3][n];
                const f32x4 gm1 = (k >= 1) ? acc[(k - 1) >> 2][0][(k - 1) & 3][n] : gh1, um1 = (k >= 1) ? acc[(k - 1) >> 2][1][(k - 1) & 3][n] : uh1;
                const f32x4 gm2 = (k >= 2) ? acc[(k - 2) >> 2][0][(k - 2) & 3][n] : (k == 1 ? gh1 : gh2), um2 = (k >= 2) ? acc[(k - 2) >> 2][1][(k - 2) & 3][n] : (k == 1 ? uh1 : uh2);
                f32x4 gg, uu, a, e;
#pragma unroll
                for (int i = 0; i < 4; ++i) { gg[i] = __builtin_fmaf(g2[i], gv[i], __builtin_fmaf(g1[i], gm1[i], __builtin_fmaf(g0[i], gm2[i], gb[i]))); uu[i] = __builtin_fmaf(u2[i], uv[i], __builtin_fmaf(u1[i], um1[i], __builtin_fmaf(u0[i], um2[i], ub[i]))); }
#pragma unroll
                for (int i = 0; i < 4; ++i) e[i] = __builtin_amdgcn_exp2f(-gg[i]);
#pragma unroll
                for (int i = 0; i < 4; ++i) { e[i] = 1.0f + e[i]; uu[i] *= gg[i]; }
#pragma unroll
                for (int i = 0; i < 4; ++i) e[i] = __builtin_amdgcn_rcpf(e[i]);
#pragma unroll
                for (int i = 0; i < 4; ++i) a[i] = uu[i] * e[i];
                typedef unsigned u32x2v __attribute__((ext_vector_type(2))); u32x2v w; w.x = cvt_pk_bf16(a[0], a[1]); w.y = cvt_pk_bf16(a[2], a[3]);
                *(u32x2v*)((char*)(ACT + (size_t)(u.pm * BM + k) * 2816 + u.pn * 128 + 4 * n) + 2u * alv) = w; } }
    }
};

template <class Epi, class Sched, bool ALIGN_EPI = false, bool SP2 = false, bool APERM = false>
__device__ __forceinline__ void gemm_phase(PG8_LAS unsigned char* lds, const Gemm g, const Sched& S, const Epi& E) {
    int tid_ = threadIdx.x; asm volatile("" : "+v"(tid_));
    const int tid = tid_, wid = __builtin_amdgcn_readfirstlane(tid >> 6), lane = tid & 63, wr = wid >> 2, wc = wid & 3, fr = lane & 15, fq = lane >> 4;
    const int K = g.K, nt = K / BK;
    unsigned voffA[2], voffB[2];
#pragma unroll
    for (int i = 0; i < 2; ++i) { int R, C; stage_rc(tid * 16 + i * 8192, R, C); const int Rb = Epi::PERM ? ((R & ~31) + perm32(R & 31)) : R;
        const int Ra = APERM ? (8 * ((R & 15) + 16 * ((R >> 6) & 1)) + ((R >> 4) & 3)) : R; voffA[i] = (unsigned)(Ra * K + C) * 2u; voffB[i] = (unsigned)(Rb * K + C) * 2u; }
    const size_t kstep = (size_t)(BK * 2);
    const size_t hstep = (size_t)HALF * K * 2;
    const size_t hstepA = APERM ? (size_t)4 * K * 2 : hstep;
    const size_t tstep = 2 * hstep;
    const unsigned ldsw = (unsigned)wid * 1024u;
    const int aoff = lds_byte(wr * 64 + fr, fq * 8), boff = lds_byte(wc * 32 + fr, fq * 8);
#define PG8_SA(b, h) (((b) * 2 + (h)) * HTB)
#define PG8_SB(b, h) ((4 + (b) * 2 + (h)) * HTB)
#define PG8_STAGE(bufoff, gbase, voff) do { _Pragma("unroll") for (int _i = 0; _i < 2; ++_i) \
        __builtin_amdgcn_global_load_lds((const unsigned*)((const char*)(gbase) + (voff)[_i]), (PG8_LAS unsigned*)(lds + (bufoff) + ldsw + _i * 8192), 16, 0, 0); } while (0)
#define PG8_LDA(dst, b, h) do { _Pragma("unroll") for (int m = 0; m < 4; ++m) _Pragma("unroll") for (int k = 0; k < 2; ++k) dst[m][k] = *(const PG8_LAS bf16x8*)(lds + PG8_SA(b, h) + aoff + m * 2048 + k * 1024); } while (0)
#define PG8_LDB(dst, b, h) do { _Pragma("unroll") for (int n = 0; n < 2; ++n) _Pragma("unroll") for (int k = 0; k < 2; ++k) dst[n][k] = *(const PG8_LAS bf16x8*)(lds + PG8_SB(b, h) + boff + n * 2048 + k * 1024); } while (0)
#define PG8_MMA_BODY(ai, bj, At, Bt) _Pragma("unroll") for (int m = 0; m < 4; ++m) _Pragma("unroll") for (int q = 0; q < 4; ++q) { const int e = (m & 1) ? 3 - q : q, n = e >> 1, k = (e & 1) ^ (e >> 1); \
        acc[ai][bj][m][n] = __builtin_amdgcn_mfma_f32_16x16x32_bf16(Bt[n][k], At[m][k], acc[ai][bj][m][n], 0, 0, 0); __builtin_amdgcn_sched_barrier(0); }
#define PG8_MMAR_BODY(ai, bj, At, Bt) _Pragma("unroll") for (int mi = 0; mi < 4; ++mi) _Pragma("unroll") for (int q = 0; q < 4; ++q) { const int m = 3 - mi, e = (mi & 1) ? 3 - q : q, n = e >> 1, k = (e & 1) ^ (e >> 1); \
        acc[ai][bj][m][n] = __builtin_amdgcn_mfma_f32_16x16x32_bf16(Bt[n][k], At[m][k], acc[ai][bj][m][n], 0, 0, 0); __builtin_amdgcn_sched_barrier(0); }
#define PG8_MMA(ai, bj, At, Bt) do { __builtin_amdgcn_s_setprio(1); PG8_MMA_BODY(ai, bj, At, Bt) __builtin_amdgcn_s_setprio(0); } while (0)
#define PG8_MMAR(ai, bj, At, Bt) do { __builtin_amdgcn_s_setprio(1); PG8_MMAR_BODY(ai, bj, At, Bt) __builtin_amdgcn_s_setprio(0); } while (0)
#define PG8_MMA2(ai, At, Ba, Bb) do { __builtin_amdgcn_s_setprio(1); PG8_MMA_BODY(ai, 0, At, Ba) PG8_MMAR_BODY(ai, 1, At, Bb) __builtin_amdgcn_s_setprio(0); } while (0)
#define PG8_WAIT_V(n) asm volatile("s_waitcnt vmcnt(" #n ")" ::: "memory")
#define PG8_WAIT_L(n) asm volatile("s_waitcnt lgkmcnt(" #n ")" ::: "memory")
#define PG8_BAR __builtin_amdgcn_s_barrier()
#define PG8_SCHED __builtin_amdgcn_sched_barrier(0)
    Unit cur, nxt; int ui = 0;
    if (!S.next(0, cur)) return;
    f32x4 acc[2][2][4][2];
#pragma unroll
    for (int a = 0; a < 2; ++a)
#pragma unroll
        for (int b = 0; b < 2; ++b)
#pragma unroll
            for (int m = 0; m < 4; ++m)
#pragma unroll
                for (int n = 0; n < 2; ++n) acc[a][b][m][n] = (f32x4){0.f, 0.f, 0.f, 0.f};
    bf16x8 At[4][2], B0[2][2], B1[2][2];
    const char* cA = (const char*)g.A + (size_t)cur.pm * tstep; const char* cB = (const char*)g.Bt + (size_t)cur.pn * tstep;
    S.a_ready(cur);
    if constexpr (SP2) {
        PG8_STAGE(PG8_SB(0, 0), cB, voffB); PG8_STAGE(PG8_SB(0, 1), cB + hstep, voffB); PG8_STAGE(PG8_SA(0, 0), cA, voffA); PG8_STAGE(PG8_SA(0, 1), cA + hstepA, voffA);
        if (wr == 1) PG8_BAR;
        PG8_WAIT_V(2); PG8_BAR;
        PG8_STAGE(PG8_SB(1, 0), cB + kstep, voffB); PG8_STAGE(PG8_SA(1, 0), cA + kstep, voffA); PG8_STAGE(PG8_SB(1, 1), cB + hstep + kstep, voffB);
        PG8_WAIT_V(6); PG8_BAR;
    } else {
        PG8_STAGE(PG8_SB(0, 0), cB, voffB); PG8_STAGE(PG8_SA(0, 0), cA, voffA); PG8_STAGE(PG8_SB(0, 1), cB + hstep, voffB); PG8_STAGE(PG8_SA(0, 1), cA + hstepA, voffA);
        if (wr == 1) PG8_BAR;
        PG8_WAIT_V(4); PG8_BAR;
        PG8_STAGE(PG8_SB(1, 0), cB + kstep, voffB); PG8_STAGE(PG8_SA(1, 0), cA + kstep, voffA); PG8_STAGE(PG8_SB(1, 1), cB + hstep + kstep, voffB);
        PG8_WAIT_V(6); PG8_BAR;
    }
    for (;;) {
        const bool has_next = S.next(ui + 1, nxt);
        const char* nA = has_next ? (const char*)g.A + (size_t)nxt.pm * tstep : cA; const char* nB = has_next ? (const char*)g.Bt + (size_t)nxt.pn * tstep : cB;
        for (int t = 0; t < nt; t += 2) {
            const bool last = (t == nt - 2);
            const char* a1 = cA + (size_t)(t + 1) * kstep;
            const char* a2 = last ? nA : cA + (size_t)(t + 2) * kstep; const char* b2 = last ? nB : cB + (size_t)(t + 2) * kstep;
            const char* a3 = a2 + kstep; const char* b3 = b2 + kstep;
            if (last && has_next) S.a_ready(nxt);
            if constexpr (SP2) {
            PG8_LDB(B0, 0, 0); PG8_LDB(B1, 0, 1); PG8_SCHED; PG8_LDA(At, 0, 0); PG8_STAGE(PG8_SA(1, 1), a1 + hstepA, voffA);
            PG8_WAIT_V(8); PG8_WAIT_L(0); PG8_BAR; PG8_MMA2(0, At, B0, B1); PG8_BAR; PG8_SCHED;
            PG8_LDA(At, 0, 1); PG8_STAGE(PG8_SB(0, 0), b2, voffB); PG8_STAGE(PG8_SB(0, 1), b2 + hstep, voffB); PG8_STAGE(PG8_SA(0, 0), a2, voffA);
            PG8_WAIT_V(8); PG8_WAIT_L(0); PG8_BAR; PG8_MMA2(1, At, B0, B1); PG8_BAR; PG8_SCHED;
            PG8_LDB(B0, 1, 0); PG8_LDB(B1, 1, 1); PG8_SCHED; PG8_LDA(At, 1, 0); PG8_STAGE(PG8_SA(0, 1), a2 + hstepA, voffA);
            PG8_WAIT_V(8); PG8_WAIT_L(0); PG8_BAR; PG8_MMA2(0, At, B0, B1); PG8_BAR; PG8_SCHED;
            PG8_LDA(At, 1, 1); PG8_STAGE(PG8_SB(1, 0), b3, voffB); PG8_STAGE(PG8_SB(1, 1), b3 + hstep, voffB); PG8_STAGE(PG8_SA(1, 0), a3, voffA);
            PG8_WAIT_V(8); PG8_WAIT_L(0); PG8_BAR; PG8_MMA2(1, At, B0, B1); PG8_BAR; PG8_SCHED;
            } else {
            PG8_LDB(B0, 0, 0); PG8_SCHED; PG8_LDA(At, 0, 0); PG8_STAGE(PG8_SA(1, 1), a1 + hstepA, voffA);
            PG8_WAIT_L(8); PG8_BAR; PG8_WAIT_L(0); PG8_MMA(0, 0, At, B0); PG8_BAR; PG8_SCHED;
            PG8_LDB(B1, 0, 1); PG8_STAGE(PG8_SB(0, 0), b2, voffB);
            PG8_BAR; PG8_WAIT_L(0); PG8_MMA(0, 1, At, B1); PG8_BAR;
            PG8_LDA(At, 0, 1); PG8_STAGE(PG8_SA(0, 0), a2, voffA);
            PG8_BAR; PG8_WAIT_L(0); PG8_MMA(1, 0, At, B0); PG8_BAR; PG8_SCHED;
            PG8_STAGE(PG8_SB(0, 1), b2 + hstep, voffB);
            PG8_WAIT_V(6); PG8_BAR; PG8_MMA(1, 1, At, B1); PG8_BAR;
            PG8_LDB(B0, 1, 0); PG8_SCHED; PG8_LDA(At, 1, 0); PG8_STAGE(PG8_SA(0, 1), a2 + hstepA, voffA);
            PG8_WAIT_L(8); PG8_BAR; PG8_WAIT_L(0); PG8_MMA(0, 0, At, B0); PG8_BAR; PG8_SCHED;
            PG8_LDB(B1, 1, 1); PG8_STAGE(PG8_SB(1, 0), b3, voffB);
            PG8_BAR; PG8_WAIT_L(0); PG8_MMA(0, 1, At, B1); PG8_BAR;
            PG8_LDA(At, 1, 1); PG8_STAGE(PG8_SA(1, 0), a3, voffA);
            PG8_BAR; PG8_WAIT_L(0); PG8_MMA(1, 0, At, B0); PG8_BAR; PG8_SCHED;
            PG8_STAGE(PG8_SB(1, 1), b3 + hstep, voffB);
            PG8_WAIT_V(6); PG8_BAR; PG8_MMA(1, 1, At, B1); PG8_BAR;
            }
        }
        if constexpr (ALIGN_EPI) { if (wr == 0) PG8_BAR; }
        if constexpr (!Epi::AFTER_DRAIN) { E(acc, cur, wr, wc, fr, fq); S.done(cur); }
        if (!has_next) break;
#pragma unroll
        for (int a = 0; a < 2; ++a)
#pragma unroll
            for (int b = 0; b < 2; ++b)
#pragma unroll
                for (int m = 0; m < 4; ++m)
#pragma unroll
                    for (int n = 0; n < 2; ++n) acc[a][b][m][n] = (f32x4){0.f, 0.f, 0.f, 0.f};
        cur = nxt; cA = nA; cB = nB; ++ui;
        if constexpr (ALIGN_EPI) { if (wr == 1) PG8_BAR; }
    }
    PG8_WAIT_V(0);
    if constexpr (!ALIGN_EPI) { if (wr == 0) PG8_BAR; }
    PG8_BAR;
    if constexpr (Epi::AFTER_DRAIN) { E.fused(acc, cur, wr, wc, fr, fq, lds, wid, lane); S.done(cur); }
#undef PG8_SA
#undef PG8_SB
#undef PG8_STAGE
#undef PG8_LDA
#undef PG8_LDB
#undef PG8_MMA
#undef PG8_MMAR
#undef PG8_MMA2
#undef PG8_MMA_BODY
#undef PG8_MMAR_BODY
#undef PG8_WAIT_V
#undef PG8_WAIT_L
#undef PG8_BAR
#undef PG8_SCHED
}
}
constexpr int NWAVES = 8;
constexpr int NB = 32, SEQ = 2048, DM = 1024, M = NB * SEQ, NMEM = 256, MM = NB * NMEM;
constexpr int AB_IN = 2304, HG_IN = 4096, DFF = 2816, UPN = 2 * DFF, MH = M / 2;
constexpr float EPS = 1e-6f;
constexpr size_t MiB = 1u << 20;
constexpr size_t WS_CTL = 0, CTL_ZERO_BYTES = 1 * MiB;
constexpr size_t WS_ROWSQ = 2 * MiB;
constexpr size_t WS_LBV = 6 * MiB;
constexpr size_t WS_OSQ = 7 * MiB;
constexpr size_t WS_ROPE = 11 * MiB;
constexpr size_t WS_MEMB = 27 * MiB;
constexpr size_t WS_KV = 43 * MiB;
constexpr size_t WS_W = 75 * MiB;
constexpr size_t WS_XB = 206 * MiB;
constexpr size_t WS_BIG = 334 * MiB;
constexpr size_t WS_HM = 622 * MiB;
constexpr size_t WS_AO = 846 * MiB;
constexpr size_t WS_ACT = WS_BIG;
constexpr size_t WS_EDGE = 686 * MiB;
constexpr size_t WS_END = 974 * MiB;
constexpr size_t W_ABIN = 0, W_ABOUT = 4718592, W_HGIN = 6815744, W_HGOUT = 15204352, W_XQ = 17301504, W_XKV = 21495808, W_XO = 29884416, W_UP = 34078720, W_DOWN = 57147392, W_TOTAL = 68681728;
static_assert(WS_W + W_TOTAL * 2 <= WS_XB && WS_BIG + (size_t)M * HG_IN * 2 <= WS_AO && WS_ACT + (size_t)M * DFF * 2 <= WS_EDGE && WS_EDGE + (size_t)(M / 128) * 4 * UPN * 4 <= WS_AO, "ws map");
static_assert(WS_BIG + (size_t)M * AB_IN * 2 <= WS_HM && WS_HM + (size_t)2 * M * 512 * 2 <= WS_AO, "ws map: head-major K/V");
constexpr int CW_BAR = 4096;
constexpr int RING_BYTES = 131072, LDSCTL_OFF = RING_BYTES, MISC_OFF = LDSCTL_OFF + 320, LDS_BYTES = 147456;

#define GAS __attribute__((address_space(1)))
#define LAS __attribute__((address_space(3)))
typedef unsigned short bf16;
typedef unsigned v4u __attribute__((ext_vector_type(4)));
typedef unsigned v2u __attribute__((ext_vector_type(2)));
typedef float f32x4 __attribute__((ext_vector_type(4)));
typedef float f32x2 __attribute__((ext_vector_type(2)));
typedef GAS unsigned gu32;
#define RLX_AGENT __ATOMIC_RELAXED, __HIP_MEMORY_SCOPE_AGENT
#define LDS_WAIT() asm volatile("s_waitcnt lgkmcnt(0)" ::: "memory")
__device__ __forceinline__ unsigned f2bf(float f) { unsigned u = __builtin_bit_cast(unsigned, f); return (u + 0x7fffu + ((u >> 16) & 1u)) >> 16; }
__device__ __forceinline__ unsigned pk2(float lo, float hi) { return f2bf(lo) | (f2bf(hi) << 16); }
__device__ __forceinline__ float bflo(unsigned w) { return __uint_as_float(w << 16); }
__device__ __forceinline__ float bfhi(unsigned w) { return __uint_as_float(w & 0xffff0000u); }
__device__ __forceinline__ float bf2f(bf16 h) { return __uint_as_float(((unsigned)h) << 16); }
__device__ __forceinline__ void unpack8(const v4u w, float* f) { f[0] = bflo(w.x); f[1] = bfhi(w.x); f[2] = bflo(w.y); f[3] = bfhi(w.y); f[4] = bflo(w.z); f[5] = bfhi(w.z); f[6] = bflo(w.w); f[7] = bfhi(w.w); }
__device__ __forceinline__ v4u pack8(const float* f) { v4u w; w.x = pk2(f[0], f[1]); w.y = pk2(f[2], f[3]); w.z = pk2(f[4], f[5]); w.w = pk2(f[6], f[7]); return w; }
__device__ __forceinline__ float wave_sum(float v) {
#pragma unroll
    for (int o = 1; o < 64; o <<= 1) v += __shfl_xor(v, o);
    return v;
}
__device__ __forceinline__ float wave_max(float v) {
#pragma unroll
    for (int o = 1; o < 64; o <<= 1) v = fmaxf(v, __shfl_xor(v, o));
    return v;
}
#define XB_TMO      128
#define XB_XCNT(j)  (256  + 64 * (j))
#define XB_XSUB(j)  (1280 + 64 * (j))
#define XB_XGEN(j)  (2304 + 64 * (j))
#define XB_TOP      3328
#define XB_TOPGEN   3392
#define XCD_BAR_WORDS 3456
#define XB_SPIN_CAP (1u << 18)

__device__ __forceinline__ unsigned xb_ld(unsigned* p)              { return __hip_atomic_load(p, __ATOMIC_RELAXED, __HIP_MEMORY_SCOPE_AGENT); }
__device__ __forceinline__ unsigned xb_add(unsigned* p, unsigned v) { return __hip_atomic_fetch_add(p, v, __ATOMIC_RELAXED, __HIP_MEMORY_SCOPE_AGENT); }
__device__ __forceinline__ unsigned xb_xcc_id() { return (unsigned)__builtin_amdgcn_s_getreg((3 << 11) | 20) & 0xFu; }
#define XB_SPIN(cond, bar) do { unsigned _sp = 0; while (cond) { __builtin_amdgcn_s_sleep(1); \
    if ((++_sp & 255u) == 0u) { if (xb_ld(&(bar)[XB_TMO])) break; if (_sp > XB_SPIN_CAP) { atomicAdd(&(bar)[XB_TMO], 1u); break; } } } } while (0)

struct XcdBarrier {
    unsigned* bar; unsigned x;
    volatile LAS unsigned* st;
};

__device__ __forceinline__ XcdBarrier xcd_barrier_post(unsigned* bar, volatile LAS unsigned* st) {
    XcdBarrier b; b.bar = bar; b.x = xb_xcc_id(); b.st = st;
    if (threadIdx.x == 0) (void)xb_add(&bar[XB_XCNT(b.x)], 1u);
    return b;
}
__device__ __forceinline__ void xcd_barrier_complete(unsigned* bar, unsigned x, unsigned& nloc, unsigned& nx) {
    const unsigned G = gridDim.x * gridDim.y * gridDim.z;
    unsigned sum, cnt, mine, sp = 0u;
    for (;;) {
        sum = 0u; cnt = 0u; mine = 0u;
#pragma unroll
        for (unsigned j = 0; j < 16; ++j) { const unsigned c = xb_ld(&bar[XB_XCNT(j)]); sum += c; cnt += (c > 0u) ? 1u : 0u; mine = (j == x) ? c : mine; }
        if (sum == G) break;
        __builtin_amdgcn_s_sleep(1);
        if ((++sp & 255u) == 0u) { if (xb_ld(&bar[XB_TMO])) break; if (sp > XB_SPIN_CAP) { atomicAdd(&bar[XB_TMO], 1u); break; } }
    }
    nloc = mine > 0u ? mine : 1u; nx = cnt > 0u ? cnt : 1u;
}

__device__ __attribute__((noinline)) void xcd_barrier(const XcdBarrier b) {
    asm volatile("s_waitcnt vmcnt(0)" ::: "memory");
    __syncthreads();
    if (threadIdx.x == 0) {
        unsigned* bar = b.bar;
        __builtin_amdgcn_s_waitcnt(0);
        unsigned nloc = b.st[0], nx = b.st[1];
        if (nloc == 0u) { xcd_barrier_complete(bar, b.x, nloc, nx); b.st[0] = nloc; b.st[1] = nx; }
        const unsigned old = xb_add(&bar[XB_XSUB(b.x)], 1u);
        const unsigned gen = old / nloc;
        if (old + 1u == (gen + 1u) * nloc) {
            __builtin_amdgcn_fence(__ATOMIC_RELEASE, "agent");
            asm volatile("s_waitcnt vmcnt(0)" ::: "memory");
            const unsigned og = xb_add(&bar[XB_TOP], 1u);
            const unsigned tg = og / nx;
            if (og + 1u == (tg + 1u) * nx) xb_add(&bar[XB_TOPGEN], 1u);
            else XB_SPIN(xb_ld(&bar[XB_TOPGEN]) == tg, bar);
            __builtin_amdgcn_fence(__ATOMIC_ACQUIRE, "agent");
            xb_add(&bar[XB_XGEN(b.x)], 1u);
            asm volatile("s_waitcnt vmcnt(0)" ::: "memory");
        } else {
            XB_SPIN(xb_ld(&bar[XB_XGEN(b.x)]) == gen, bar);
            __builtin_amdgcn_fence(__ATOMIC_ACQUIRE, "agent");
            asm volatile("s_waitcnt vmcnt(0)" ::: "memory");
        }
    }
    __syncthreads();
}
struct Frame {
    LAS unsigned char* lds; volatile LAS unsigned* MISC; gu32* ctl;
    int tid, lane, wave, vcu, G, gw, NGW, gtid, NT;
};
__device__ __forceinline__ Frame fresh(const Frame&) { extern __shared__ __attribute__((aligned(16))) unsigned char lds_[]; Frame F; int t = threadIdx.x; asm volatile("" : "+v"(t)); int bx = blockIdx.x; asm volatile("" : "+s"(bx));
    F.lds = (LAS unsigned char*)lds_; F.MISC = nullptr; F.ctl = nullptr; F.G = gridDim.x; F.vcu = (F.G % 8 == 0) ? (bx % 8) * (F.G / 8) + bx / 8 : bx; F.wave = __builtin_amdgcn_readfirstlane(t >> 6);
    F.NGW = F.G * NWAVES; F.NT = F.G * NWAVES * 64; F.tid = t; F.lane = t & 63; F.gw = F.vcu * NWAVES + F.wave; F.gtid = F.vcu * (NWAVES * 64) + t; return F; }

__device__ __forceinline__ void p0_transpose_item(const float* W, int K, int N, bf16* WT, LAS float* scr, int item, int lane, const float* gain, int mode) {
    const int nblk = N / 32, kb = item / nblk, nb = item % nblk, k0 = 64 * kb, n0 = 32 * nb;
    float wv[32], gv[32];
#pragma unroll
    for (int i = 0; i < 32; ++i) { const int kk = 2 * i + (lane >> 5); wv[i] = W[(size_t)(k0 + kk) * N + n0 + (lane & 31)]; gv[i] = gain ? gain[k0 + kk] : 1.f; }
#pragma unroll
    for (int i = 0; i < 32; ++i) { const int kk = 2 * i + (lane >> 5); scr[kk * 33 + (lane & 31)] = wv[i] * gv[i]; }
    LDS_WAIT(); asm volatile("" ::: "memory");
    int rbase = n0; if (mode == 1) { const int isup = n0 >= DFF ? 1 : 0; const int c = n0 - isup * DFF; rbase = (c / 128) * 256 + isup * 128 + (c % 128); }
    const int c = lane & 7;
#pragma unroll
    for (int j = 0; j < 4; ++j) { const int n = (lane >> 3) + 8 * j; const LAS float* s = scr + (8 * c) * 33 + n;
        v4u o; o.x = pk2(s[0 * 33], s[1 * 33]); o.y = pk2(s[2 * 33], s[3 * 33]); o.z = pk2(s[4 * 33], s[5 * 33]); o.w = pk2(s[6 * 33], s[7 * 33]);
        *(v4u*)(WT + (size_t)(rbase + n) * K + k0 + 8 * c) = o; }
    LDS_WAIT(); asm volatile("" ::: "memory");
}
__device__ __forceinline__ void p0_weights(Frame& F, const float* W, int cnt, int K, int N, bf16* WT, const float* gain, int gain_stride, int mode) {
    LAS float* scr = (LAS float*)(F.lds + F.wave * 16384);
    const int per = (K / 64) * (N / 32);
    for (int it = F.gw; it < cnt * per; it += F.NGW) { const int i = it / per, r = it % per;
        p0_transpose_item(W + (size_t)i * K * N, K, N, WT + (size_t)i * K * N, scr, r, F.lane, gain ? gain + (size_t)i * gain_stride : nullptr, mode); }
}
__device__ __forceinline__ void sincos_rev(double rev, float& s, float& c) {
    const double q = floor(rev * 4.0 + 0.5); const double r = (rev - q * 0.25) * 6.283185307179586476925; const double r2 = r * r;
    const double sn = r * (1.0 + r2 * (-1.0 / 6 + r2 * (1.0 / 120 + r2 * (-1.0 / 5040 + r2 * (1.0 / 362880 + r2 * (-1.0 / 39916800))))));
    const double cs = 1.0 + r2 * (-0.5 + r2 * (1.0 / 24 + r2 * (-1.0 / 720 + r2 * (1.0 / 40320 + r2 * (-1.0 / 3628800 + r2 * (1.0 / 479001600))))));
    const int qi = ((int)q) & 3;
    const double ss = (qi == 0) ? sn : (qi == 1) ? cs : (qi == 2) ? -sn : -cs;
    const double cc = (qi == 0) ? cs : (qi == 1) ? -sn : (qi == 2) ? -cs : sn;
    s = (float)ss; c = (float)cc;
}
typedef const __attribute__((address_space(4))) unsigned char* kaptr_t;
__device__ __forceinline__ const void* in_ptr(int i) { kaptr_t ka = (kaptr_t)__builtin_amdgcn_kernarg_segment_ptr(); asm volatile("" : "+s"(ka)); return *(const void* const __attribute__((address_space(4)))*)(ka + 8 * i); }
#define INF(i) ((const float*)in_ptr(i))
#define OUTP() ((float*)in_ptr(25))
#define WSP() ((unsigned char*)in_ptr(26))
enum { I_X = 0, I_MEM, I_POS, I_NORM_MIX, I_NORM_CROSS, I_NORM_MEM, I_NORM_FFN, I_AB_W_IN, I_AB_W_OUT, I_SWA_Q_NORM, I_SWA_K_NORM, I_SWA_SINKS, I_HGRN_W_IN, I_HGRN_W_OUT, I_HGRN_O_NORM, I_HGRN_LB,
       I_XA_W_Q, I_XA_W_KV, I_XA_W_O, I_XA_Q_NORM, I_XA_K_NORM, I_FFN_W_UP, I_FFN_CONV_W, I_FFN_CONV_B, I_FFN_W_DOWN };
__device__ __forceinline__ void p0_prologue(const Frame& F0) {
    unsigned char* ws = WSP();
    Frame F = fresh(F0);
    bf16* W = (bf16*)(ws + WS_W);
    p0_weights(F, INF(I_AB_W_IN), 2, DM, AB_IN, W + W_ABIN, INF(I_NORM_MIX), 2 * DM, 0);
    p0_weights(F, INF(I_AB_W_OUT), 2, DM, DM, W + W_ABOUT, nullptr, 0, 0);
    p0_weights(F, INF(I_HGRN_W_IN), 2, DM, HG_IN, W + W_HGIN, INF(I_NORM_MIX) + DM, 2 * DM, 0);
    p0_weights(F, INF(I_HGRN_W_OUT), 2, DM, DM, W + W_HGOUT, nullptr, 0, 0);
    p0_weights(F, INF(I_XA_W_Q), 4, DM, DM, W + W_XQ, INF(I_NORM_CROSS), DM, 0);
    p0_weights(F, INF(I_XA_W_KV), 4, DM, 2 * DM, W + W_XKV, INF(I_NORM_MEM), DM, 0);
    p0_weights(F, INF(I_XA_W_O), 4, DM, DM, W + W_XO, nullptr, 0, 0);
    p0_weights(F, INF(I_FFN_W_UP), 4, DM, UPN, W + W_UP, INF(I_NORM_FFN), DM, 1);
    p0_weights(F, INF(I_FFN_W_DOWN), 4, DFF, DM, W + W_DOWN, nullptr, 0, 0);
    bf16* XB = (bf16*)(ws + WS_XB); float* ROWSQ = (float*)(ws + WS_ROWSQ); const float* xin = INF(I_X);
    for (int m0 = F.gw * 4; m0 < M; m0 += F.NGW * 4) {
        f32x4 v[4][4];
#pragma unroll
        for (int r = 0; r < 4; ++r) { const f32x4* xr = (const f32x4*)(xin + (size_t)(m0 + r) * DM) + F.lane;
#pragma unroll
            for (int j = 0; j < 4; ++j) v[r][j] = xr[64 * j]; }
#pragma unroll
        for (int r = 0; r < 4; ++r) { float s = 0.f; v2u* o8 = (v2u*)(XB + (size_t)(m0 + r) * DM) + F.lane;
#pragma unroll
            for (int j = 0; j < 4; ++j) { const f32x4 t = v[r][j]; s += (t.x * t.x + t.y * t.y) + (t.z * t.z + t.w * t.w); v2u w; w.x = pk2(t.x, t.y); w.y = pk2(t.z, t.w); o8[64 * j] = w; }
            s = wave_sum(s); if (F.lane < 16) ROWSQ[(size_t)(m0 + r) * 16 + F.lane] = (F.lane == 0) ? s : 0.f; } }
    bf16* MEMB = (bf16*)(ws + WS_MEMB); const float* memin = INF(I_MEM);
    for (int m = F.gw; m < MM; m += F.NGW) { const f32x4* xr = (const f32x4*)(memin + (size_t)m * DM) + F.lane; float s = 0.f; f32x4 v[4]; v2u* o8 = (v2u*)(MEMB + (size_t)m * DM) + F.lane;
#pragma unroll
        for (int j = 0; j < 4; ++j) { v[j] = xr[64 * j]; s += (v[j].x * v[j].x + v[j].y * v[j].y) + (v[j].z * v[j].z + v[j].w * v[j].w); }
        const float r = 1.0f / sqrtf(wave_sum(s) * (1.0f / DM) + EPS);
#pragma unroll
        for (int j = 0; j < 4; ++j) { v2u w; w.x = pk2(v[j].x * r, v[j].y * r); w.y = pk2(v[j].z * r, v[j].w * r); o8[64 * j] = w; } }
    f32x2* ROPE = (f32x2*)(ws + WS_ROPE); const int* posp = (const int*)in_ptr(I_POS);
    for (int idx = F.gtid; idx < M * 32; idx += F.NT) { const int tok = idx >> 5, i = idx & 31;
        const float inv = (float)exp(-(double)i * (9.210340371976182736 / 32.0)); const float ang = (float)posp[tok] * inv;
        double rev = (double)ang * 0.15915494309189533577; rev -= floor(rev); float s, c; sincos_rev(rev, s, c); ROPE[idx] = (f32x2){c, s}; }
    float* LBV = (float*)(ws + WS_LBV); const float* hlb = INF(I_HGRN_LB);
    for (int c = F.gtid; c < DM; c += F.NT) { const float a0 = hlb[c], a1 = hlb[DM + c], a2 = hlb[2 * DM + c], a3 = hlb[3 * DM + c];
        const float mx = fmaxf(fmaxf(a0, a1), fmaxf(a2, a3)); const float e0 = expf(a0 - mx), e1 = expf(a1 - mx), e2 = expf(a2 - mx), e3 = expf(a3 - mx); const float inv = 1.0f / (((e0 + e1) + e2) + e3);
        const float p0 = e0 * inv, p1 = e1 * inv, p2 = e2 * inv, p3 = e3 * inv;
        LBV[c] = (p0 + p1) - p0; LBV[DM + c] = (((p0 + p1) + p2) + p3) - p0; }
}

__device__ __forceinline__ void swa_kprep(const Frame& F0, bf16* PROJ, const f32x2* ROPE, const float* knorm) {
    Frame F = fresh(F0);
    for (int idx = F.gtid; idx < M * 2; idx += F.NT) { const int tok = idx >> 1, kvh = idx & 1; bf16* kp = PROJ + (size_t)tok * AB_IN + 512 + kvh * 64;
        float f[64]; float ss = 0.f;
#pragma unroll
        for (int i = 0; i < 8; ++i) unpack8(((const v4u*)kp)[i], f + 8 * i);
#pragma unroll
        for (int d = 0; d < 64; ++d) ss += f[d] * f[d];
        const float r = 1.0f / sqrtf(ss * (1.0f / 64) + EPS);
#pragma unroll
        for (int d = 0; d < 64; ++d) f[d] *= r * knorm[d];
        const f32x2* tb = ROPE + (size_t)tok * 32;
#pragma unroll
        for (int i = 0; i < 32; ++i) { const f32x2 cs = tb[i]; const float a = f[i], b = f[i + 32]; f[i] = a * cs.x - b * cs.y; f[i + 32] = b * cs.x + a * cs.y; }
#pragma unroll
        for (int i = 0; i < 8; ++i) ((v4u*)kp)[i] = pack8(f + 8 * i); }
}
__device__ __forceinline__ void swa_naive(const Frame& F0, const bf16* PROJ, bf16* AO, const f32x2* ROPE, const float* qnorm, const float* sinks) {
    Frame F = fresh(F0);
    for (int task = F.gw; task < 8192; task += F.NGW) { const int blk = task & 31, hq = (task >> 5) & 7, b = task >> 8; const int T0 = blk * 64, t = T0 + F.lane, tok = b * SEQ + t;
        float q[64]; float ss = 0.f; const bf16* qp = PROJ + (size_t)tok * AB_IN + hq * 64;
#pragma unroll
        for (int i = 0; i < 8; ++i) unpack8(((const v4u*)qp)[i], q + 8 * i);
#pragma unroll
        for (int d = 0; d < 64; ++d) ss += q[d] * q[d];
        const float r = 0.125f / sqrtf(ss * (1.0f / 64) + EPS);
#pragma unroll
        for (int d = 0; d < 64; ++d) q[d] *= r * qnorm[d];
        const f32x2* tb = ROPE + (size_t)tok * 32;
#pragma unroll
        for (int i = 0; i < 32; ++i) { const f32x2 cs = tb[i]; const float a = q[i], bb = q[i + 32]; q[i] = a * cs.x - bb * cs.y; q[i + 32] = bb * cs.x + a * cs.y; }
        float m = sinks[hq], l = 1.f; float o[64];
#pragma unroll
        for (int d = 0; d < 64; ++d) o[d] = 0.f;
        const int kvh = hq >> 2; const int slo = (T0 - 127) > 0 ? (T0 - 127) : 0;
        for (int s = slo; s <= T0 + 63; ++s) { const bf16* kr = PROJ + (size_t)(b * SEQ + s) * AB_IN + 512 + kvh * 64; float sc = 0.f;
#pragma unroll
            for (int i = 0; i < 8; ++i) { float kf[8]; unpack8(((const v4u*)kr)[i], kf);
#pragma unroll
                for (int j = 0; j < 8; ++j) sc += q[8 * i + j] * kf[j]; }
            const bool valid = (s <= t) && (t - s < 128);
            const float mn = valid ? fmaxf(m, sc) : m; const float alpha = __expf(m - mn); const float p = valid ? __expf(sc - mn) : 0.f; l = l * alpha + p; m = mn;
#pragma unroll
            for (int i = 0; i < 8; ++i) { float vf[8]; unpack8(((const v4u*)(kr + 128))[i], vf);
#pragma unroll
                for (int j = 0; j < 8; ++j) o[8 * i + j] = o[8 * i + j] * alpha + p * vf[j]; } }
        const float inv = 1.0f / l; bf16* op = AO + (size_t)tok * DM + hq * 64;
#pragma unroll
        for (int d = 0; d < 64; ++d) o[d] *= inv;
#pragma unroll
        for (int i = 0; i < 8; ++i) ((v4u*)op)[i] = pack8(o + 8 * i); }
}
__device__ __forceinline__ void sb_naive(const Frame& F0, const bf16* PROJ, bf16* AO) {
    Frame F = fresh(F0);
    for (int task = F.gw; task < 8192; task += F.NGW) { const int rr = task >> 11, g = task & 2047; const int braw = g & 31, bh = rr * 64 + (g >> 5), blk = (rr & 1) ? 31 - braw : braw; const int b = bh >> 3, h = bh & 7;
        const int T0 = blk * 64, t = T0 + F.lane, tok = b * SEQ + t;
        float q[64]; const bf16* qp = PROJ + (size_t)tok * AB_IN + 768 + h * 64;
#pragma unroll
        for (int i = 0; i < 8; ++i) unpack8(((const v4u*)qp)[i], q + 8 * i);
#pragma unroll
        for (int d = 0; d < 64; ++d) q[d] *= 0.125f;
        float la = 0.f; float o[64];
#pragma unroll
        for (int d = 0; d < 64; ++d) o[d] = 0.f;
        for (int s = T0 + 62; s >= 0; --s) { const bf16* kr = PROJ + (size_t)(b * SEQ + s) * AB_IN + 1280 + h * 64; float z = 0.f;
#pragma unroll
            for (int i = 0; i < 8; ++i) { float kf[8]; unpack8(((const v4u*)kr)[i], kf);
#pragma unroll
                for (int j = 0; j < 8; ++j) z += q[8 * i + j] * kf[j]; }
            const bool valid = s < t;
            const float sp = fmaxf(z, 0.f) + log1pf(__expf(-fabsf(z)));
            const float a = valid ? __expf(z - sp + la) : 0.f; la -= valid ? sp : 0.f;
#pragma unroll
            for (int i = 0; i < 8; ++i) { float vf[8]; unpack8(((const v4u*)(kr + 512))[i], vf);
#pragma unroll
                for (int j = 0; j < 8; ++j) o[8 * i + j] += a * vf[j]; } }
        bf16* op = AO + (size_t)tok * DM + 512 + h * 64;
#pragma unroll
        for (int i = 0; i < 8; ++i) ((v4u*)op)[i] = pack8(o + 8 * i); }
}
__device__ __forceinline__ void hgrn_naive(const Frame& F0, const bf16* PROJ, bf16* AO, float* OSQ, const float* lbv) {
    Frame F = fresh(F0);
    if (F.wave < 2) { const int task = F.vcu * 2 + F.wave; if (task < 512) { const int b = task >> 4, h = (task >> 1) & 7, half = task & 1, e = half * 64 + F.lane;
        LAS float* sh = (LAS float*)(F.lds + F.wave * 2048); const LAS f32x4* sh4 = (const LAS f32x4*)sh;
        float S[128];
#pragma unroll
        for (int d = 0; d < 128; ++d) S[d] = 0.f;
        const float lb0 = lbv[h * 128 + F.lane], lb1 = lbv[h * 128 + 64 + F.lane];
        for (int t = 0; t < SEQ; ++t) { const size_t tok = (size_t)b * SEQ + t; const bf16* row = PROJ + tok * HG_IN + h * 128;
            const float q0 = bf2f(row[F.lane]), q1 = bf2f(row[64 + F.lane]), z0 = bf2f(row[1024 + F.lane]), z1 = bf2f(row[1024 + 64 + F.lane]), v = bf2f(row[2048 + e]);
            const float sg0 = 1.0f / (1.0f + __expf(-z0)), sg1 = 1.0f / (1.0f + __expf(-z1));
            sh[F.lane] = q0; sh[64 + F.lane] = q1; sh[128 + F.lane] = lb0 + (1.0f - lb0) * sg0; sh[192 + F.lane] = lb1 + (1.0f - lb1) * sg1;
            sh[256 + F.lane] = (1.0f - lb0) * (1.0f - sg0); sh[320 + F.lane] = (1.0f - lb1) * (1.0f - sg1);
            LDS_WAIT(); asm volatile("" ::: "memory");
            float o = 0.f;
#pragma unroll
            for (int d4 = 0; d4 < 32; ++d4) { const f32x4 qq = sh4[d4], ff = sh4[32 + d4], kk = sh4[64 + d4];
#pragma unroll
                for (int i = 0; i < 4; ++i) { S[4 * d4 + i] = ff[i] * S[4 * d4 + i] + kk[i] * v; o += qq[i] * S[4 * d4 + i]; } }
            LDS_WAIT(); asm volatile("" ::: "memory");
            AO[tok * DM + h * 128 + e] = (bf16)f2bf(o);
            const float ssum = wave_sum(o * o); if (F.lane == 0) OSQ[tok * 16 + h * 2 + half] = ssum; } } }
}
__device__ __forceinline__ void hgrn_post(const Frame& F0, const bf16* PROJ, bf16* AO, const float* OSQ, const float* onorm) {
    Frame F = fresh(F0);
    for (int idx = F.gtid; idx < M * 128; idx += F.NT) { const size_t tok = (size_t)(idx >> 7); const int col = (idx & 127) * 8, h = col >> 7;
        float o[8], g[8]; unpack8(*(const v4u*)(AO + tok * DM + col), o); unpack8(*(const v4u*)(PROJ + tok * HG_IN + 3072 + col), g);
        const float r = 1.0f / sqrtf((OSQ[tok * 16 + h * 2] + OSQ[tok * 16 + h * 2 + 1]) * (1.0f / 128) + EPS);
#pragma unroll
        for (int i = 0; i < 8; ++i) o[i] = o[i] * r * onorm[(col & 127) + i] * (g[i] / (1.0f + __expf(-g[i])));
        *(v4u*)(AO + tok * DM + col) = pack8(o); }
}
__device__ __forceinline__ void cross_naive(const Frame& F0, const bf16* Q, const bf16* KV, bf16* AO, const float* gq, const float* gk) {
    Frame F = fresh(F0);
    LAS float* P = (LAS float*)(F.lds + F.wave * 8192);
    for (int task = F.gw; task < 32768; task += F.NGW) { const int r0 = (task & 255) * 8, hd = (task >> 8) & 3, b = task >> 10;
        const bf16* qb = Q + (size_t)(b * SEQ + r0) * DM + hd * 256; const bf16* kb = KV + (size_t)(b * NMEM) * 2048 + hd * 256;
        float s[8][4], qss[8], kss[4];
#pragma unroll
        for (int r = 0; r < 8; ++r) { qss[r] = 0.f;
#pragma unroll
            for (int j = 0; j < 4; ++j) s[r][j] = 0.f; }
#pragma unroll
        for (int j = 0; j < 4; ++j) kss[j] = 0.f;
#pragma unroll 1
        for (int dc = 0; dc < 32; ++dc) { float G8[8], kf[4][8];
#pragma unroll
            for (int i = 0; i < 8; ++i) G8[i] = gq[dc * 8 + i] * gk[dc * 8 + i];
#pragma unroll
            for (int j = 0; j < 4; ++j) { unpack8(*(const v4u*)(kb + (size_t)(F.lane + 64 * j) * 2048 + dc * 8), kf[j]);
#pragma unroll
                for (int i = 0; i < 8; ++i) kss[j] += kf[j][i] * kf[j][i]; }
#pragma unroll
            for (int r = 0; r < 8; ++r) { float qf[8]; unpack8(*(const v4u*)(qb + (size_t)r * DM + dc * 8), qf);
#pragma unroll
                for (int i = 0; i < 8; ++i) { qss[r] += qf[i] * qf[i]; qf[i] *= G8[i]; }
#pragma unroll
                for (int j = 0; j < 4; ++j)
#pragma unroll
                    for (int i = 0; i < 8; ++i) s[r][j] += qf[i] * kf[j][i]; } }
        float rk[4];
#pragma unroll
        for (int j = 0; j < 4; ++j) rk[j] = 1.0f / sqrtf(kss[j] * (1.0f / 256) + EPS);
#pragma unroll
        for (int r = 0; r < 8; ++r) { const float rq = 0.0625f / sqrtf(qss[r] * (1.0f / 256) + EPS); float mx = -3.0e38f;
#pragma unroll
            for (int j = 0; j < 4; ++j) { s[r][j] *= rq * rk[j]; mx = fmaxf(mx, s[r][j]); }
            mx = wave_max(mx); float sum = 0.f;
#pragma unroll
            for (int j = 0; j < 4; ++j) { s[r][j] = __expf(s[r][j] - mx); sum += s[r][j]; }
            sum = wave_sum(sum); const float inv = 1.0f / sum;
#pragma unroll
            for (int j = 0; j < 4; ++j) P[r * 256 + F.lane + 64 * j] = s[r][j] * inv; }
        LDS_WAIT(); asm volatile("" ::: "memory");
        float o[8][4];
#pragma unroll
        for (int r = 0; r < 8; ++r)
#pragma unroll
            for (int i = 0; i < 4; ++i) o[r][i] = 0.f;
        const bf16* vb = KV + (size_t)(b * NMEM) * 2048 + 1024 + hd * 256 + F.lane * 4;
#pragma unroll 1
        for (int m4 = 0; m4 < 64; ++m4) {
            f32x4 pr[8];
#pragma unroll
            for (int r = 0; r < 8; ++r) pr[r] = *(const LAS f32x4*)(P + r * 256 + m4 * 4);
#pragma unroll
            for (int mm = 0; mm < 4; ++mm) { const v2u vw = *(const v2u*)(vb + (size_t)(m4 * 4 + mm) * 2048); const float v0 = bflo(vw.x), v1 = bfhi(vw.x), v2 = bflo(vw.y), v3 = bfhi(vw.y);
#pragma unroll
                for (int r = 0; r < 8; ++r) { const float p = pr[r][mm]; o[r][0] += p * v0; o[r][1] += p * v1; o[r][2] += p * v2; o[r][3] += p * v3; } } }
        LDS_WAIT(); asm volatile("" ::: "memory");
#pragma unroll
        for (int r = 0; r < 8; ++r) { v2u w; w.x = pk2(o[r][0], o[r][1]); w.y = pk2(o[r][2], o[r][3]); *(v2u*)(AO + (size_t)(b * SEQ + r0 + r) * DM + hd * 256 + F.lane * 4) = w; } }
}
__device__ __forceinline__ void conv_naive(const Frame& F0, const bf16* U, bf16* ACT, const float* cw, const float* cb) {
    Frame F = fresh(F0);
    for (int idx = F.gtid; idx < MH * 22 * 16; idx += F.NT) { const int c8 = idx & 15; const int rj = idx >> 4; const int j = rj % 22, row = rj / 22; const int t = row & (SEQ - 1); const int ch = j * 128 + c8 * 8;
        const bf16* up = U + (size_t)row * UPN + j * 256 + c8 * 8;
        float g0[8], u0[8], g1[8], u1[8], g2[8], u2[8];
        unpack8(*(const v4u*)up, g0); unpack8(*(const v4u*)(up + 128), u0);
        if (t >= 1) { unpack8(*(const v4u*)(up - UPN), g1); unpack8(*(const v4u*)(up - UPN + 128), u1); } else {
#pragma unroll
            for (int i = 0; i < 8; ++i) { g1[i] = 0.f; u1[i] = 0.f; } }
        if (t >= 2) { unpack8(*(const v4u*)(up - 2 * UPN), g2); unpack8(*(const v4u*)(up - 2 * UPN + 128), u2); } else {
#pragma unroll
            for (int i = 0; i < 8; ++i) { g2[i] = 0.f; u2[i] = 0.f; } }
        float o[8];
#pragma unroll
        for (int i = 0; i < 8; ++i) { const int cg = ch + i, cu = DFF + ch + i;
            const float gg = cw[2 * UPN + cg] * g0[i] + cw[UPN + cg] * g1[i] + cw[cg] * g2[i] + cb[cg];
            const float uu = cw[2 * UPN + cu] * u0[i] + cw[UPN + cu] * u1[i] + cw[cu] * u2[i] + cb[cu];
            o[i] = (gg / (1.0f + __expf(-gg))) * uu; }
        *(v4u*)(ACT + (size_t)row * DFF + ch) = pack8(o); }
}
__device__ __forceinline__ void ffn_fix(const Frame& F0, const float* EDGE, bf16* ACT, const float* cw, const float* cb) {
    Frame F = fresh(F0);
    for (int idx = F.gtid; idx < (M / 128) * 352; idx += F.NT) { const int strip = idx / 352, c8 = idx - strip * 352, ch = c8 * 8, colg = 256 * (ch >> 7) + (ch & 127); const bool hp = ((strip * 128) & (SEQ - 1)) != 0;
        const float* e0 = EDGE + (size_t)strip * 4 * UPN; const float* ep = e0 - (hp ? 4 * UPN : 0);
        float o0[8], o1[8];
#pragma unroll
        for (int hlf = 0; hlf < 2; ++hlf) {
            const int col = colg + 128 * hlf, wc0 = hlf * DFF + ch; float r0[8], r1[8], p2[8], p3[8], w0[8], w1[8], w2[8], bb[8];
#pragma unroll
            for (int q = 0; q < 2; ++q) { const f32x4 a = *(const f32x4*)(e0 + col + 4 * q), b = *(const f32x4*)(e0 + UPN + col + 4 * q), c = *(const f32x4*)(ep + 2 * UPN + col + 4 * q), d = *(const f32x4*)(ep + 3 * UPN + col + 4 * q);
                const f32x4 x0 = *(const f32x4*)(cw + wc0 + 4 * q), x1 = *(const f32x4*)(cw + UPN + wc0 + 4 * q), x2 = *(const f32x4*)(cw + 2 * UPN + wc0 + 4 * q), xb = *(const f32x4*)(cb + wc0 + 4 * q);
#pragma unroll
                for (int i = 0; i < 4; ++i) { r0[4 * q + i] = a[i]; r1[4 * q + i] = b[i]; p2[4 * q + i] = hp ? c[i] : 0.f; p3[4 * q + i] = hp ? d[i] : 0.f; w0[4 * q + i] = x0[i]; w1[4 * q + i] = x1[i]; w2[4 * q + i] = x2[i]; bb[4 * q + i] = xb[i]; } }
#pragma unroll
            for (int i = 0; i < 8; ++i) { const float y0 = w2[i] * r0[i] + w1[i] * p3[i] + w0[i] * p2[i] + bb[i], y1 = w2[i] * r1[i] + w1[i] * r0[i] + w0[i] * p3[i] + bb[i];
                if (hlf == 0) { o0[i] = y0 / (1.0f + __expf(-y0)); o1[i] = y1 / (1.0f + __expf(-y1)); } else { o0[i] *= y0; o1[i] *= y1; } } }
        *(v4u*)(ACT + (size_t)(strip * 128) * DFF + ch) = pack8(o0); *(v4u*)(ACT + (size_t)(strip * 128 + 1) * DFF + ch) = pack8(o1); }
}
typedef short bf16x8 __attribute__((ext_vector_type(8)));
typedef unsigned u32x4s __attribute__((ext_vector_type(4)));
typedef short s16x4 __attribute__((ext_vector_type(4)));
typedef short v4i16_t __attribute__((ext_vector_type(4)));
typedef float f32x16 __attribute__((ext_vector_type(16)));
constexpr float LOG2E = 1.4426950408889634f;
__device__ __forceinline__ int img_off(int row, int ch, int c16) { return (row >> 3) * c16 + 512 * (ch >> 2) + 64 * (row & 7) + 16 * ((ch & 3) ^ ((row >> 2) & 3)); }
struct ImgLane { int rd0, rd1, tr0, tr1, wr; };
__device__ __forceinline__ ImgLane img_lane(int lane, int tid) { ImgLane L; const int r32 = lane & 31, h = lane >> 5, blk = (lane >> 4) & 1, q = (lane & 15) >> 2, p = lane & 3;
    L.rd0 = (r32 >> 3) * 1024 + 64 * (r32 & 7) + 16 * (h ^ ((r32 >> 2) & 3)); L.rd1 = L.rd0 ^ 32;
    L.tr0 = 64 * (4 * h + q) + 16 * ((2 * blk + (p >> 1)) ^ h) + 8 * (p & 1); L.tr1 = L.tr0 ^ 32;
    L.wr = img_off(tid >> 3, tid & 7, 1024); return L; }
#define IMG_ROW_READ(img, L, rb, s) (*(const LAS bf16x8*)((img) + (((s) & 1) ? (L).rd1 : (L).rd0) + 4096 * (rb) + 512 * ((s) >> 1)))
__device__ __forceinline__ s16x4 tr_rd(const LAS unsigned char* p) { return __builtin_bit_cast(s16x4, __builtin_amdgcn_ds_read_tr16_b64_v4i16((LAS v4i16_t*)p)); }
#define IMG_TR_FRAG_ACC(dst, img, L, k0, c) do { const s16x4 lo_ = tr_rd((img) + (L).tr0 + ((k0) >> 3) * 1024 + 512 * (c)), hi_ = tr_rd((img) + (L).tr1 + (((k0) >> 3) + 1) * 1024 + 512 * (c)); \
    dst = (bf16x8){lo_[0], lo_[1], lo_[2], lo_[3], hi_[0], hi_[1], hi_[2], hi_[3]}; } while (0)
__device__ __forceinline__ unsigned cvtpk(float lo, float hi) { unsigned r; asm("s_nop 0\n\tv_cvt_pk_bf16_f32 %0, %1, %2" : "=v"(r) : "v"(lo), "v"(hi)); return r; }
__device__ __forceinline__ bf16x8 pack_acc(const f32x16& a, int s) { v4u w; w.x = cvtpk(a[8 * s + 0], a[8 * s + 1]); w.y = cvtpk(a[8 * s + 2], a[8 * s + 3]); w.z = cvtpk(a[8 * s + 4], a[8 * s + 5]); w.w = cvtpk(a[8 * s + 6], a[8 * s + 7]);
    asm volatile("s_nop 1" : "+v"(w));
    return __builtin_bit_cast(bf16x8, w); }
__device__ __forceinline__ float sumsq8(const v4u w) { float f[8]; unpack8(w, f); return ((f[0] * f[0] + f[1] * f[1]) + (f[2] * f[2] + f[3] * f[3])) + ((f[4] * f[4] + f[5] * f[5]) + (f[6] * f[6] + f[7] * f[7])); }
#define MFMA32(a, b, c) __builtin_amdgcn_mfma_f32_32x32x16_bf16((a), (b), (c), 0, 0, 0)
#define WG_BAR() do { asm volatile("s_waitcnt vmcnt(0) lgkmcnt(0)" ::: "memory"); __builtin_amdgcn_s_barrier(); asm volatile("" ::: "memory"); } while (0)
#define WG_BAR_LDS() do { asm volatile("s_waitcnt lgkmcnt(0)" ::: "memory"); __builtin_amdgcn_s_barrier(); asm volatile("" ::: "memory"); } while (0)

__device__ __forceinline__ void cross_mfma(const Frame& F0, const bf16* Q, const bf16* KV, bf16* AO, const float* gq, const float* gk) {
    Frame F = fresh(F0);
    LAS unsigned char* const buf0 = F.lds; LAS unsigned char* const buf1 = F.lds + 65536;
    float M0; { float g = 0.f;
#pragma unroll
        for (int j = 0; j < 4; ++j) g = fmaxf(g, fabsf(gq[F.lane + 64 * j] * gk[F.lane + 64 * j]));
        M0 = __uint_as_float(__builtin_amdgcn_readfirstlane(__float_as_uint(wave_max(g) * (16.0f * LOG2E)))); }
    for (int unit = F.vcu; unit < 1024; unit += F.G) { const int qb = unit & 7, hd = (unit >> 3) & 3, b = unit >> 5;
        int tid2 = threadIdx.x; asm volatile("" : "+v"(tid2));
        const int lane = tid2 & 63, w = F.wave, r32 = lane & 31, h = lane >> 5, prow = tid2 >> 3, pch = tid2 & 7;
        const ImgLane L = img_lane(lane, tid2);
        const int prow2 = prow;
        const bf16* kbase = KV + (size_t)(b * NMEM) * 2048 + hd * 256 + (size_t)prow2 * 2048 + 8 * pch; const bf16* vbase = kbase + 1024;
        const size_t tok = (size_t)b * SEQ + qb * 256 + w * 32 + r32;
        const bf16* qrow = Q + tok * DM + hd * 256 + 8 * h;
        v4u qn[4]; float qss = 0.f, rq = 0.f, l = 0.f;
#pragma unroll
        for (int s = 0; s < 4; ++s) qn[s] = *(const v4u*)(qrow + 16 * s);
        f32x16 acc[4];
#pragma unroll
        for (int kb = 0; kb < 4; ++kb)
#pragma unroll
            for (int i = 0; i < 16; ++i) acc[kb][i] = 0.f;
        bf16x8 pf[8][2];
        v4u pre[8];
#define XK_LOAD(KH_) do { _Pragma("unroll") for (int c = 0; c < 4; ++c) _Pragma("unroll") for (int i = 0; i < 2; ++i) pre[2 * c + i] = *(const v4u*)(kbase + (size_t)(128 * (KH_) + 64 * i) * 2048 + 64 * c); } while (0)
#define XV_LOAD(VH_) do { _Pragma("unroll") for (int j = 0; j < 2; ++j) _Pragma("unroll") for (int i = 0; i < 4; ++i) pre[4 * j + i] = *(const v4u*)(vbase + (size_t)(64 * i) * 2048 + 64 * (2 * (VH_) + j)); } while (0)
        XK_LOAD(0);
        float linv = 0.f;
#pragma unroll
        for (int kh = 0; kh < 2; ++kh) { LAS unsigned char* const buf = kh ? buf1 : buf0;
#pragma unroll
            for (int c = 0; c < 4; ++c)
#pragma unroll
                for (int i = 0; i < 2; ++i) *(LAS v4u*)(buf + 16384 * c + L.wr + 8192 * i) = pre[2 * c + i];
            WG_BAR_LDS();
            if (kh == 0) XK_LOAD(1); else XV_LOAD(0);
#pragma unroll
            for (int dc = 0; dc < 4; ++dc) {
                bf16x8 qf[4];
#pragma unroll
                for (int s = 0; s < 4; ++s) { if (kh == 0) qss += sumsq8(qn[s]); qf[s] = __builtin_bit_cast(bf16x8, qn[s]); }
                if (!(kh == 1 && dc == 3)) {
#pragma unroll
                    for (int s = 0; s < 4; ++s) qn[s] = *(const v4u*)(qrow + 64 * ((dc + 1) & 3) + 16 * s); }
                if (kh == 0 && dc == 3) { qss += __shfl_xor(qss, 32); rq = (0.0625f * LOG2E) / sqrtf(qss * (1.0f / 256) + EPS); }
#pragma unroll
                for (int kb = 0; kb < 4; ++kb) { __builtin_amdgcn_s_setprio(1);
#pragma unroll
                    for (int s = 0; s < 4; ++s) acc[kb] = MFMA32(IMG_ROW_READ(buf + 16384 * dc, L, kb, s), qf[s], acc[kb]);
                    __builtin_amdgcn_s_setprio(0); asm volatile("" ::: "memory"); }
                __builtin_amdgcn_sched_barrier(0); }
#pragma unroll
            for (int kb = 0; kb < 4; ++kb) { asm volatile("" : "+v"(acc[kb]) :: "memory");
#pragma unroll
                for (int i = 0; i < 16; ++i) { const float p = __builtin_amdgcn_exp2f(__builtin_fmaf(acc[kb][i], rq, -M0)); acc[kb][i] = p; l += p; }
                pf[kh * 4 + kb][0] = pack_acc(acc[kb], 0); pf[kh * 4 + kb][1] = pack_acc(acc[kb], 1);
#pragma unroll
                for (int i = 0; i < 16; ++i) acc[kb][i] = 0.f; }
            __builtin_amdgcn_sched_barrier(0);
        }
        l += __shfl_xor(l, 32); linv = 1.0f / l;
#pragma unroll
        for (int vh = 0; vh < 2; ++vh) { LAS unsigned char* const buf = vh ? buf1 : buf0;
#pragma unroll
            for (int j = 0; j < 2; ++j)
#pragma unroll
                for (int i = 0; i < 4; ++i) *(LAS v4u*)(buf + 32768 * j + L.wr + 8192 * i) = pre[4 * j + i];
            WG_BAR_LDS();
            if (vh == 0) XV_LOAD(1);
#pragma unroll
            for (int j = 0; j < 2; ++j) { const int vc = 2 * vh + j;
                f32x16 o[2];
#pragma unroll
                for (int c = 0; c < 2; ++c) {
#pragma unroll
                    for (int i = 0; i < 16; ++i) o[c][i] = 0.f;
#pragma unroll
                    for (int kb = 0; kb < 8; ++kb) { __builtin_amdgcn_s_setprio(1);
#pragma unroll
                        for (int s = 0; s < 2; ++s) { bf16x8 vf; IMG_TR_FRAG_ACC(vf, buf + 32768 * j, L, 32 * kb + 16 * s, c); o[c] = MFMA32(vf, pf[kb][s], o[c]); }
                        __builtin_amdgcn_s_setprio(0); asm volatile("" ::: "memory"); } }
                bf16* op = AO + tok * DM + hd * 256 + 64 * vc + 4 * h;
#pragma unroll
                for (int c = 0; c < 2; ++c)
#pragma unroll
                    for (int g = 0; g < 4; ++g) { v2u wv; wv.x = cvtpk(o[c][4 * g] * linv, o[c][4 * g + 1] * linv); wv.y = cvtpk(o[c][4 * g + 2] * linv, o[c][4 * g + 3] * linv); *(v2u*)(op + 32 * c + 8 * g) = wv; }
                __builtin_amdgcn_sched_barrier(0); }
        }
#undef XK_LOAD
#undef XV_LOAD
    }
    WG_BAR();
}
constexpr float SB_ZSCALE = 0.125f * LOG2E;
template <bool MASKED>
__device__ __forceinline__ void sb_block(const LAS unsigned char* kimg, const LAS unsigned char* vimg, const ImgLane& L, const int kb, const bf16x8 (&qf)[4], f32x16 (&o)[2], float& K, const int key0, const int t, const int h) {
    f32x16 z;
#pragma unroll
    for (int i = 0; i < 16; ++i) z[i] = 0.f;
#pragma unroll
    for (int s = 0; s < 4; ++s) z = MFMA32(IMG_ROW_READ(kimg, L, kb, s), qf[s], z);
    float R[16];
#pragma unroll
    for (int r = 0; r < 16; ++r) { float E = __builtin_amdgcn_exp2f(z[r] * SB_ZSCALE);
        if (MASKED) { const int key = key0 + (r & 3) + 8 * (r >> 2) + 4 * h; E = (key < t) ? E : 0.f; }
        R[r] = __builtin_amdgcn_rcpf(1.0f + E); }
    float G[4], Gp[4], T[4];
#pragma unroll
    for (int g = 0; g < 4; ++g) { G[g] = (R[4 * g] * R[4 * g + 1]) * (R[4 * g + 2] * R[4 * g + 3]); Gp[g] = __shfl_xor(G[g], 32); T[g] = G[g] * Gp[g]; }
    float after[4]; after[3] = K; after[2] = K * T[3]; after[1] = after[2] * T[2]; after[0] = after[1] * T[1];
#pragma unroll
    for (int g = 0; g < 4; ++g) { const float S3 = after[g] * (h == 0 ? Gp[g] : 1.0f), S2 = S3 * R[4 * g + 3], S1 = S2 * R[4 * g + 2], S0 = S1 * R[4 * g + 1], Sm = S0 * R[4 * g];
        z[4 * g + 3] = S3 - S2; z[4 * g + 2] = S2 - S1; z[4 * g + 1] = S1 - S0; z[4 * g + 0] = S0 - Sm; }
    K = after[0] * T[0];
    const bf16x8 p0 = pack_acc(z, 0), p1 = pack_acc(z, 1);
#pragma unroll
    for (int c = 0; c < 2; ++c) { bf16x8 vf; IMG_TR_FRAG_ACC(vf, vimg, L, 32 * kb, c); o[c] = MFMA32(vf, p0, o[c]); IMG_TR_FRAG_ACC(vf, vimg, L, 32 * kb + 16, c); o[c] = MFMA32(vf, p1, o[c]); }
}
__device__ __forceinline__ void sb_tile2(const LAS unsigned char* kimg, const LAS unsigned char* vimg, const ImgLane& L, const bf16x8 (&qf)[4], f32x16 (&o)[2], float& K, const int h) {
    f32x16 z[2];
#pragma unroll
    for (int b = 0; b < 2; ++b)
#pragma unroll
        for (int i = 0; i < 16; ++i) z[b][i] = 0.f;
#pragma unroll
    for (int s = 0; s < 4; ++s) z[1] = MFMA32(IMG_ROW_READ(kimg, L, 1, s), qf[s], z[1]);
#pragma unroll
    for (int s = 3; s >= 0; --s) z[0] = MFMA32(IMG_ROW_READ(kimg, L, 0, s), qf[s], z[0]);
    float R[2][16];
#pragma unroll
    for (int b = 0; b < 2; ++b)
#pragma unroll
        for (int r = 0; r < 16; ++r) { const float E = __builtin_amdgcn_exp2f(z[b][r] * SB_ZSCALE); R[b][r] = __builtin_amdgcn_rcpf(1.0f + E); }
    float G[2][4], Gp[2][4], T[2][4];
#pragma unroll
    for (int b = 0; b < 2; ++b)
#pragma unroll
        for (int g = 0; g < 4; ++g) G[b][g] = (R[b][4 * g] * R[b][4 * g + 1]) * (R[b][4 * g + 2] * R[b][4 * g + 3]);
#pragma unroll
    for (int b = 0; b < 2; ++b)
#pragma unroll
        for (int g = 0; g < 4; ++g) Gp[b][g] = __shfl_xor(G[b][g], 32);
#pragma unroll
    for (int b = 0; b < 2; ++b)
#pragma unroll
        for (int g = 0; g < 4; ++g) T[b][g] = G[b][g] * Gp[b][g];
    const float K1 = K, K0 = K * ((T[1][0] * T[1][1]) * (T[1][2] * T[1][3]));
#pragma unroll
    for (int b = 0; b < 2; ++b) { float after[4]; after[3] = b ? K1 : K0; after[2] = after[3] * T[b][3]; after[1] = after[2] * T[b][2]; after[0] = after[1] * T[b][1];
#pragma unroll
        for (int g = 0; g < 4; ++g) { const float S3 = after[g] * (h == 0 ? Gp[b][g] : 1.0f), S2 = S3 * R[b][4 * g + 3], S1 = S2 * R[b][4 * g + 2], S0 = S1 * R[b][4 * g + 1], Sm = S0 * R[b][4 * g];
            z[b][4 * g + 3] = S3 - S2; z[b][4 * g + 2] = S2 - S1; z[b][4 * g + 1] = S1 - S0; z[b][4 * g + 0] = S0 - Sm; }
        if (b == 0) K = after[0] * T[0][0]; }
    const bf16x8 p10 = pack_acc(z[1], 0), p11 = pack_acc(z[1], 1), p00 = pack_acc(z[0], 0), p01 = pack_acc(z[0], 1);
#pragma unroll
    for (int c = 0; c < 2; ++c) { bf16x8 vf; IMG_TR_FRAG_ACC(vf, vimg, L, 32, c); o[c] = MFMA32(vf, p10, o[c]); IMG_TR_FRAG_ACC(vf, vimg, L, 48, c); o[c] = MFMA32(vf, p11, o[c]);
        IMG_TR_FRAG_ACC(vf, vimg, L, 0, c); o[c] = MFMA32(vf, p00, o[c]); IMG_TR_FRAG_ACC(vf, vimg, L, 16, c); o[c] = MFMA32(vf, p01, o[c]); }
}
#ifndef SB_EXIT_BITS
#define SB_EXIT_BITS 0x00008000u
#endif
__device__ __forceinline__ void sb_mfma(const Frame& F0, const bf16* PROJ, const bf16* HM, bf16* AO) {
    Frame F = fresh(F0);
    const int lane = F.lane, w = F.wave, r32 = lane & 31, h = lane >> 5;
    const ImgLane L = img_lane(lane, F.tid);
    LAS unsigned* const done = (LAS unsigned*)(F.lds + 131072 + 1024);
    if (lane < 2) done[lane * 8 + w] = 0u;
    WG_BAR_LDS();
    unsigned tag = 0u; int fi = 0;
    for (int bh = F.vcu; bh < 256; bh += F.G) { const int b = bh >> 3, hh = bh & 7;
        const bf16* kvb = HM + ((size_t)bh * SEQ + (F.tid >> 3)) * 64 + 8 * (F.tid & 7);
        constexpr size_t VOFF = (size_t)M * 512;
        v4u pk[4], pv[4];
#define SB_LOAD(T_) do { _Pragma("unroll") for (int i = 0; i < 4; ++i) { pk[i] = *(const v4u*)(kvb + (size_t)(256 * (T_) + 64 * i) * 64); pv[i] = *(const v4u*)(kvb + (size_t)(256 * (T_) + 64 * i) * 64 + VOFF); } } while (0)
#define SB_STORE(buf_) do { _Pragma("unroll") for (int i = 0; i < 4; ++i) { *(LAS v4u*)((buf_) + L.wr + 8192 * i) = pk[i]; *(LAS v4u*)((buf_) + 32768 + L.wr + 8192 * i) = pv[i]; } } while (0)
#define SB_WZ() (__all(__float_as_uint(carry) < SB_EXIT_BITS) != 0)
#define SB_ALLDONE(res_) do { const u32x4s d0_ = *(const LAS u32x4s*)(done + (fi & 1) * 8), d1_ = *(const LAS u32x4s*)(done + (fi & 1) * 8 + 4); \
            const unsigned mn_ = min(min(min(d0_.x, d0_.y), min(d0_.z, d0_.w)), min(min(d1_.x, d1_.y), min(d1_.z, d1_.w))); res_ = (unsigned)__builtin_amdgcn_readfirstlane(mn_) >= tag; ++fi; } while (0)
        SB_LOAD(0);
#pragma unroll 1
        for (int qb = 0; qb < 8; ++qb) { const int q0 = 256 * qb + 32 * w, t = q0 + r32; const size_t tok = (size_t)b * SEQ + t;
            bf16x8 qf[4];
#pragma unroll
            for (int s = 0; s < 4; ++s) qf[s] = __builtin_bit_cast(bf16x8, *(const v4u*)(PROJ + tok * AB_IN + 768 + hh * 64 + 16 * s + 8 * h));
            __builtin_amdgcn_s_waitcnt(0x0F70);
            f32x16 o[2];
#pragma unroll
            for (int c = 0; c < 2; ++c)
#pragma unroll
                for (int i = 0; i < 16; ++i) o[c][i] = 0.f;
            float carry = 1.f;
            ++tag; bool wz = false;
            LAS unsigned char* const own = F.lds + (qb & 1) * 65536; LAS unsigned char* const prev = F.lds + ((qb & 1) ^ 1) * 65536;
            SB_STORE(own);
            WG_BAR_LDS();
            if (qb < 7) SB_LOAD(qb + 1);
            { const int hb = w >> 1, j = 4 * qb + hb; const LAS unsigned char* const kimg = own + 8192 * hb; const LAS unsigned char* const vimg = own + 32768 + 8192 * hb;
              if (64 * j + 32 < q0 + 31) sb_block<true>(kimg, vimg, L, 1, qf, o, carry, 64 * j + 32, t, h);
              if (64 * j + 31 < q0) sb_block<false>(kimg, vimg, L, 0, qf, o, carry, 64 * j, t, h); else sb_block<true>(kimg, vimg, L, 0, qf, o, carry, 64 * j, t, h); }
            { const int n = (w >> 1) + (qb > 0 ? 4 : 0);
#pragma unroll 1
              for (int i = 0; i < n; ++i) { if (wz) break; const int hb = (w >> 1) - 1 - i; const LAS unsigned char* const base = (hb >= 0) ? own + 8192 * hb : prev + 8192 * (hb + 4);
                  sb_tile2(base, base + 32768, L, qf, o, carry, h); wz = SB_WZ(); } }
            if (wz && lane == 0) done[(fi & 1) * 8 + w] = tag;
            WG_BAR_LDS();
            if (qb >= 2) { bool alld; SB_ALLDONE(alld);
                if (!alld) {
#pragma unroll 1
                    for (int T = qb - 2; T >= 0; --T) { SB_LOAD(T); SB_STORE(prev); WG_BAR_LDS();
#pragma unroll 1
                        for (int hb = 3; hb >= 0; --hb) { if (wz) break; sb_tile2(prev + 8192 * hb, prev + 32768 + 8192 * hb, L, qf, o, carry, h); wz = SB_WZ(); }
                        if (wz && lane == 0) done[(fi & 1) * 8 + w] = tag;
                        WG_BAR_LDS();
                        SB_ALLDONE(alld); if (alld) break; }
                    if (qb < 7) SB_LOAD(qb + 1); } }
            bf16* op = AO + tok * DM + 512 + hh * 64 + 4 * h;
#pragma unroll
            for (int c = 0; c < 2; ++c)
#pragma unroll
                for (int g = 0; g < 4; ++g) { v2u wv; wv.x = cvtpk(o[c][4 * g], o[c][4 * g + 1]); wv.y = cvtpk(o[c][4 * g + 2], o[c][4 * g + 3]); *(v2u*)(op + 32 * c + 8 * g) = wv; }
        }
#undef SB_LOAD
#undef SB_STORE
#undef SB_WZ
#undef SB_ALLDONE
    }
    WG_BAR();
}
struct ImgLaneW { int rd0, rd1, tr0, tr1, n0, n1, qp; };
__device__ __forceinline__ ImgLaneW img_lane_w(int lane) { ImgLaneW L; const int r32 = lane & 31, h = lane >> 5, blk = (lane >> 4) & 1, q = (lane & 15) >> 2, p = lane & 3, x = (r32 >> 2) & 3;
    L.rd0 = (r32 >> 3) * 2048 + 64 * (r32 & 7) + 16 * (h ^ x); L.rd1 = L.rd0 ^ 32;
    L.tr0 = 64 * (4 * h + q) + 16 * ((2 * blk + (p >> 1)) ^ h) + 8 * (p & 1); L.tr1 = L.tr0 ^ 32;
    L.n0 = h * 2048 + 64 * q + 16 * ((2 * blk + (p >> 1)) ^ (2 * h)) + 8 * (p & 1); L.n1 = (L.n0 ^ 16) + 256;
    L.qp = (r32 >> 3) * 2048 + 64 * (r32 & 7) + 16 * x + 8 * h; return L; }
#define IMGW_ROW_READ(img, L, s) (*(const LAS bf16x8*)((img) + (((s) & 1) ? (L).rd1 : (L).rd0) + 512 * ((s) >> 1)))
#define IMGW_TR_FRAG_ACC(dst, img, L, k0, c) do { const s16x4 lo_ = tr_rd((img) + (L).tr0 + ((k0) >> 3) * 2048 + 512 * (c)), hi_ = tr_rd((img) + (L).tr1 + (((k0) >> 3) + 1) * 2048 + 512 * (c)); \
    dst = (bf16x8){lo_[0], lo_[1], lo_[2], lo_[3], hi_[0], hi_[1], hi_[2], hi_[3]}; } while (0)
#define IMGW_TR_FRAG_NAT(dst, img, L, k0, c) do { const s16x4 lo_ = tr_rd((img) + (L).n0 + ((k0) >> 3) * 2048 + 512 * (c)), hi_ = tr_rd((img) + (L).n1 + ((k0) >> 3) * 2048 + 512 * (c)); \
    dst = (bf16x8){lo_[0], lo_[1], lo_[2], lo_[3], hi_[0], hi_[1], hi_[2], hi_[3]}; } while (0)
#define IMGW_ROW_FRAG_ACC(dst, img, L, db, ks) do { const v2u lo_ = *(const LAS v2u*)((img) + ((L).qp ^ (32 * (ks))) + 512 * (db)), hi_ = *(const LAS v2u*)((img) + ((L).qp ^ (32 * (ks) + 16)) + 512 * (db)); \
    dst = __builtin_bit_cast(bf16x8, (v4u){lo_.x, lo_.y, hi_.x, hi_.y}); } while (0)
__device__ __forceinline__ float scan32(float x) {
    asm volatile("s_nop 4\n\tv_add_f32_dpp %0, %0, %0 row_shr:1 row_mask:0xf bank_mask:0xf bound_ctrl:1" : "+v"(x));
    asm volatile("s_nop 1\n\tv_add_f32_dpp %0, %0, %0 row_shr:2 row_mask:0xf bank_mask:0xf bound_ctrl:1" : "+v"(x));
    asm volatile("s_nop 1\n\tv_add_f32_dpp %0, %0, %0 row_shr:4 row_mask:0xf bank_mask:0xf bound_ctrl:1" : "+v"(x));
    asm volatile("s_nop 1\n\tv_add_f32_dpp %0, %0, %0 row_shr:8 row_mask:0xf bank_mask:0xf bound_ctrl:1" : "+v"(x));
    asm volatile("s_nop 1\n\tv_add_f32_dpp %0, %0, %0 row_bcast:15 row_mask:0xa bank_mask:0xf" : "+v"(x));
    return x; }
__device__ __forceinline__ void scan32x8(float (&x)[8]) {
    asm volatile(
        "s_nop 4\n\t"
        "v_add_f32_dpp %0, %0, %0 row_shr:1 row_mask:0xf bank_mask:0xf bound_ctrl:1\n\tv_add_f32_dpp %1, %1, %1 row_shr:1 row_mask:0xf bank_mask:0xf bound_ctrl:1\n\tv_add_f32_dpp %2, %2, %2 row_shr:1 row_mask:0xf bank_mask:0xf bound_ctrl:1\n\tv_add_f32_dpp %3, %3, %3 row_shr:1 row_mask:0xf bank_mask:0xf bound_ctrl:1\n\tv_add_f32_dpp %4, %4, %4 row_shr:1 row_mask:0xf bank_mask:0xf bound_ctrl:1\n\tv_add_f32_dpp %5, %5, %5 row_shr:1 row_mask:0xf bank_mask:0xf bound_ctrl:1\n\tv_add_f32_dpp %6, %6, %6 row_shr:1 row_mask:0xf bank_mask:0xf bound_ctrl:1\n\tv_add_f32_dpp %7, %7, %7 row_shr:1 row_mask:0xf bank_mask:0xf bound_ctrl:1\n\t"
        "v_add_f32_dpp %0, %0, %0 row_shr:2 row_mask:0xf bank_mask:0xf bound_ctrl:1\n\tv_add_f32_dpp %1, %1, %1 row_shr:2 row_mask:0xf bank_mask:0xf bound_ctrl:1\n\tv_add_f32_dpp %2, %2, %2 row_shr:2 row_mask:0xf bank_mask:0xf bound_ctrl:1\n\tv_add_f32_dpp %3, %3, %3 row_shr:2 row_mask:0xf bank_mask:0xf bound_ctrl:1\n\tv_add_f32_dpp %4, %4, %4 row_shr:2 row_mask:0xf bank_mask:0xf bound_ctrl:1\n\tv_add_f32_dpp %5, %5, %5 row_shr:2 row_mask:0xf bank_mask:0xf bound_ctrl:1\n\tv_add_f32_dpp %6, %6, %6 row_shr:2 row_mask:0xf bank_mask:0xf bound_ctrl:1\n\tv_add_f32_dpp %7, %7, %7 row_shr:2 row_mask:0xf bank_mask:0xf bound_ctrl:1\n\t"
        "v_add_f32_dpp %0, %0, %0 row_shr:4 row_mask:0xf bank_mask:0xf bound_ctrl:1\n\tv_add_f32_dpp %1, %1, %1 row_shr:4 row_mask:0xf bank_mask:0xf bound_ctrl:1\n\tv_add_f32_dpp %2, %2, %2 row_shr:4 row_mask:0xf bank_mask:0xf bound_ctrl:1\n\tv_add_f32_dpp %3, %3, %3 row_shr:4 row_mask:0xf bank_mask:0xf bound_ctrl:1\n\tv_add_f32_dpp %4, %4, %4 row_shr:4 row_mask:0xf bank_mask:0xf bound_ctrl:1\n\tv_add_f32_dpp %5, %5, %5 row_shr:4 row_mask:0xf bank_mask:0xf bound_ctrl:1\n\tv_add_f32_dpp %6, %6, %6 row_shr:4 row_mask:0xf bank_mask:0xf bound_ctrl:1\n\tv_add_f32_dpp %7, %7, %7 row_shr:4 row_mask:0xf bank_mask:0xf bound_ctrl:1\n\t"
        "v_add_f32_dpp %0, %0, %0 row_shr:8 row_mask:0xf bank_mask:0xf bound_ctrl:1\n\tv_add_f32_dpp %1, %1, %1 row_shr:8 row_mask:0xf bank_mask:0xf bound_ctrl:1\n\tv_add_f32_dpp %2, %2, %2 row_shr:8 row_mask:0xf bank_mask:0xf bound_ctrl:1\n\tv_add_f32_dpp %3, %3, %3 row_shr:8 row_mask:0xf bank_mask:0xf bound_ctrl:1\n\tv_add_f32_dpp %4, %4, %4 row_shr:8 row_mask:0xf bank_mask:0xf bound_ctrl:1\n\tv_add_f32_dpp %5, %5, %5 row_shr:8 row_mask:0xf bank_mask:0xf bound_ctrl:1\n\tv_add_f32_dpp %6, %6, %6 row_shr:8 row_mask:0xf bank_mask:0xf bound_ctrl:1\n\tv_add_f32_dpp %7, %7, %7 row_shr:8 row_mask:0xf bank_mask:0xf bound_ctrl:1\n\t"
        "v_add_f32_dpp %0, %0, %0 row_bcast:15 row_mask:0xa bank_mask:0xf\n\tv_add_f32_dpp %1, %1, %1 row_bcast:15 row_mask:0xa bank_mask:0xf\n\tv_add_f32_dpp %2, %2, %2 row_bcast:15 row_mask:0xa bank_mask:0xf\n\tv_add_f32_dpp %3, %3, %3 row_bcast:15 row_mask:0xa bank_mask:0xf\n\tv_add_f32_dpp %4, %4, %4 row_bcast:15 row_mask:0xa bank_mask:0xf\n\tv_add_f32_dpp %5, %5, %5 row_bcast:15 row_mask:0xa bank_mask:0xf\n\tv_add_f32_dpp %6, %6, %6 row_bcast:15 row_mask:0xa bank_mask:0xf\n\tv_add_f32_dpp %7, %7, %7 row_bcast:15 row_mask:0xa bank_mask:0xf\n\t"
        : "+v"(x[0]), "+v"(x[1]), "+v"(x[2]), "+v"(x[3]), "+v"(x[4]), "+v"(x[5]), "+v"(x[6]), "+v"(x[7]));
}
__device__ __forceinline__ float lane_of_half(float x, int l, int h) {
    const float a = __uint_as_float(__builtin_amdgcn_readlane(__float_as_uint(x), l)), b = __uint_as_float(__builtin_amdgcn_readlane(__float_as_uint(x), 32 + l)); return h ? b : a; }
constexpr int HG_QI = 0, HG_KI = 8192, HG_VI = 16384, HG_DEC = 24576, HG_OP = 26624, HG_OPS = 132;
__device__ __forceinline__ void hgrn_mfma(const Frame& F0, const bf16* PROJ, bf16* AO, const float* lbv, const float* onorm) {
    Frame F = fresh(F0);
    const int lane = F.lane, w = F.wave, r32 = lane & 31, h = lane >> 5, es = w & 3, dh = w >> 2;
    const ImgLaneW L = img_lane_w(lane);
    const int pt = lane & 31, dg = 2 * w + (lane >> 5), d0 = dg * 8, et = F.tid >> 4, eg = F.tid & 15;
    LAS unsigned char* const QI = F.lds + HG_QI; LAS unsigned char* const KI = F.lds + HG_KI; LAS unsigned char* const VI = F.lds + HG_VI;
    LAS unsigned char* const QB = F.lds + 61440;
    LAS float* const DEC = (LAS float*)(F.lds + HG_DEC); LAS float* const OP = (LAS float*)(F.lds + HG_OP);
    const int wr = img_off(pt, dg, 2048);
    for (int bh = F.vcu; bh < 256; bh += F.G) { const int b = bh >> 3, hh = bh & 7;
        float lb[8], om[8], on8[8];
#pragma unroll
        for (int i = 0; i < 8; ++i) { lb[i] = lbv[hh * 128 + d0 + i]; om[i] = 1.0f - lb[i]; on8[i] = onorm[eg * 8 + i]; }
        f32x16 S[2];
#pragma unroll
        for (int i = 0; i < 2; ++i)
#pragma unroll
            for (int j = 0; j < 16; ++j) S[i][j] = 0.f;
        const bf16* prow = PROJ + (size_t)(b * SEQ + pt) * HG_IN + hh * 128 + d0;
        const bf16* grow = PROJ + (size_t)(b * SEQ + et) * HG_IN + 3072 + hh * 128 + eg * 8;
        bf16* orow = AO + (size_t)(b * SEQ + et) * DM + hh * 128 + eg * 8;
        v4u nq = *(const v4u*)prow, nz = *(const v4u*)(prow + 1024), nv = *(const v4u*)(prow + 2048), ng = *(const v4u*)grow;
#pragma unroll 1
        for (int c = 0; c < 64; ++c) {
            float q8[8], z8[8], g8[8]; unpack8(nq, q8); unpack8(nz, z8); unpack8(ng, g8); const v4u vraw = nv;
            if (c < 63) { const size_t o = (size_t)(c + 1) * 32 * HG_IN; nq = *(const v4u*)(prow + o); nz = *(const v4u*)(prow + o + 1024); nv = *(const v4u*)(prow + o + 2048); ng = *(const v4u*)(grow + o); }
            float bb[8], k8[8];
#pragma unroll
            for (int i = 0; i < 8; ++i) { const float sg = __builtin_amdgcn_rcpf(1.0f + __builtin_amdgcn_exp2f(-z8[i] * LOG2E)); bb[i] = __builtin_amdgcn_logf(lb[i] + om[i] * sg); k8[i] = om[i] - om[i] * sg; }
            scan32x8(bb);
            float qh[8], kh[8], qb[8];
            float r8[8];
#pragma unroll
            for (int i = 0; i < 8; ++i) r8[i] = __shfl(bb[i], 15 + 32 * h);
#pragma unroll
            for (int i = 0; i < 8; ++i) { const float r = r8[i]; const float fq = __builtin_amdgcn_exp2f(bb[i] - r);
                qh[i] = q8[i] * fq; kh[i] = k8[i] * fminf(__builtin_amdgcn_rcpf(fq), 1.2676506e30f);
                const float eb = __builtin_amdgcn_exp2f(bb[i]);
                qb[i] = q8[i] * eb;
                if (pt == 31) { DEC[128 + d0 + i] = eb; DEC[256 + d0 + i] = fq; } }
            { v4u t; t.x = cvtpk(qh[0], qh[1]); t.y = cvtpk(qh[2], qh[3]); t.z = cvtpk(qh[4], qh[5]); t.w = cvtpk(qh[6], qh[7]); *(LAS v4u*)(QI + wr) = t;
              t.x = cvtpk(qb[0], qb[1]); t.y = cvtpk(qb[2], qb[3]); t.z = cvtpk(qb[4], qb[5]); t.w = cvtpk(qb[6], qb[7]); *(LAS v4u*)(QB + wr) = t;
              t.x = cvtpk(kh[0], kh[1]); t.y = cvtpk(kh[2], kh[3]); t.z = cvtpk(kh[4], kh[5]); t.w = cvtpk(kh[6], kh[7]); *(LAS v4u*)(KI + wr) = t; *(LAS v4u*)(VI + wr) = vraw; }
            WG_BAR_LDS();
            f32x16 X;
#pragma unroll
            for (int j = 0; j < 16; ++j) X[j] = 0.f;
#pragma unroll
            for (int kd = 0; kd < 8; ++kd) X = MFMA32(IMGW_ROW_READ(KI, L, kd), IMGW_ROW_READ(QI, L, kd), X);
#pragma unroll
            for (int j = 0; j < 16; ++j) { const int s = (j & 3) + 8 * (j >> 2) + 4 * h; X[j] = (s <= r32) ? X[j] : 0.f; }
            f32x16 o; const f32x16 zero16 = {0.f, 0.f, 0.f, 0.f, 0.f, 0.f, 0.f, 0.f, 0.f, 0.f, 0.f, 0.f, 0.f, 0.f, 0.f, 0.f};
            { bf16x8 vf, px; IMGW_TR_FRAG_ACC(vf, VI, L, 16 * dh, es); if (dh == 0) px = pack_acc(X, 0); else px = pack_acc(X, 1); o = MFMA32(px, vf, zero16); }
#pragma unroll
            for (int i = 0; i < 2; ++i) { bf16x8 af;
                IMGW_ROW_FRAG_ACC(af, QB, L, 2 * dh + i, 0); o = MFMA32(af, pack_acc(S[i], 0), o); IMGW_ROW_FRAG_ACC(af, QB, L, 2 * dh + i, 1); o = MFMA32(af, pack_acc(S[i], 1), o); }
#pragma unroll
            for (int j = 0; j < 16; ++j) { const int t = (j & 3) + 8 * (j >> 2) + 4 * h; OP[(dh * 32 + t) * HG_OPS + 32 * es + r32] = o[j]; }
#pragma unroll
            for (int i = 0; i < 2; ++i) { const int db = 2 * dh + i; f32x16 T;
                bf16x8 af, bf;
                IMGW_TR_FRAG_NAT(af, KI, L, 0, 2 * dh + i); IMGW_TR_FRAG_NAT(bf, VI, L, 0, es); T = MFMA32(af, bf, zero16); IMGW_TR_FRAG_NAT(af, KI, L, 16, 2 * dh + i); IMGW_TR_FRAG_NAT(bf, VI, L, 16, es); T = MFMA32(af, bf, T);
#pragma unroll
                for (int g = 0; g < 4; ++g) { const f32x4 d1 = *(const LAS f32x4*)(DEC + 128 + 32 * db + 8 * g + 4 * h), d2 = *(const LAS f32x4*)(DEC + 256 + 32 * db + 8 * g + 4 * h);
#pragma unroll
                    for (int j = 0; j < 4; ++j) { const float s1 = S[i][4 * g + j] * d1[j]; S[i][4 * g + j] = __builtin_fmaf(T[4 * g + j], d2[j], s1); } } }
            WG_BAR_LDS();
            { const f32x4 a0 = *(const LAS f32x4*)(OP + et * HG_OPS + 8 * eg), a1 = *(const LAS f32x4*)(OP + et * HG_OPS + 8 * eg + 4), b0 = *(const LAS f32x4*)(OP + (32 + et) * HG_OPS + 8 * eg), b1 = *(const LAS f32x4*)(OP + (32 + et) * HG_OPS + 8 * eg + 4);
              float ov[8] = {a0[0] + b0[0], a0[1] + b0[1], a0[2] + b0[2], a0[3] + b0[3], a1[0] + b1[0], a1[1] + b1[1], a1[2] + b1[2], a1[3] + b1[3]};
              float ss = ((ov[0] * ov[0] + ov[1] * ov[1]) + (ov[2] * ov[2] + ov[3] * ov[3])) + ((ov[4] * ov[4] + ov[5] * ov[5]) + (ov[6] * ov[6] + ov[7] * ov[7]));
              ss += __shfl_xor(ss, 1); ss += __shfl_xor(ss, 2); ss += __shfl_xor(ss, 4); ss += __shfl_xor(ss, 8);
              const float rr = __builtin_amdgcn_rsqf(ss * (1.0f / 128) + EPS);
#pragma unroll
              for (int i = 0; i < 8; ++i) ov[i] = ov[i] * rr * on8[i] * (g8[i] * __builtin_amdgcn_rcpf(1.0f + __builtin_amdgcn_exp2f(-g8[i] * LOG2E)));
              v4u t; t.x = cvtpk(ov[0], ov[1]); t.y = cvtpk(ov[2], ov[3]); t.z = cvtpk(ov[4], ov[5]); t.w = cvtpk(ov[6], ov[7]);
              *(v4u*)(orow + (size_t)c * 32 * DM) = t; }
        }
    }
    WG_BAR();
}
__device__ __forceinline__ void swa_mfma(const Frame& F0, const bf16* PROJ, bf16* AO, const f32x2* ROPE, const float* qnorm, const float* knorm, const float* sinks) {
    Frame F = fresh(F0);
    const int lane = F.lane, w = F.wave, r32 = lane & 31, h = lane >> 5, g = w >> 1;
    const ImgLane L = img_lane(lane, F.tid);
    LAS unsigned char* const KI = F.lds; LAS unsigned char* const VI = F.lds + 32768;
    for (int unit = F.vcu; unit < 1024; unit += F.G) { const int qb = unit & 15, kvh = (unit >> 4) & 1, b = unit >> 5; const int key00 = 128 * (qb - 1);
#pragma unroll
        for (int i = 0; i < 2; ++i) { const int id = F.tid + 512 * i, kr = id >> 2, c = id & 3, key = key00 + kr; const bool kv = key >= 0; const size_t tokk = (size_t)b * SEQ + (kv ? key : 0);
            const bf16* p = PROJ + tokk * AB_IN + 512 + kvh * 64 + 8 * c; v4u a = *(const v4u*)p, bq = *(const v4u*)(p + 32);
            float x1[8], x2[8]; unpack8(a, x1); unpack8(bq, x2); float ss = 0.f;
#pragma unroll
            for (int j = 0; j < 8; ++j) ss += x1[j] * x1[j] + x2[j] * x2[j];
            ss += __shfl_xor(ss, 1); ss += __shfl_xor(ss, 2);
            const float r = kv ? 1.0f / sqrtf(ss * (1.0f / 64) + EPS) : 0.f; const f32x2* tb = ROPE + tokk * 32 + 8 * c;
#pragma unroll
            for (int j = 0; j < 8; ++j) { const f32x2 cs = tb[j]; const float y1 = x1[j] * r * knorm[8 * c + j], y2 = x2[j] * r * knorm[32 + 8 * c + j]; x1[j] = y1 * cs.x - y2 * cs.y; x2[j] = y2 * cs.x + y1 * cs.y; }
            a.x = cvtpk(x1[0], x1[1]); a.y = cvtpk(x1[2], x1[3]); a.z = cvtpk(x1[4], x1[5]); a.w = cvtpk(x1[6], x1[7]); bq.x = cvtpk(x2[0], x2[1]); bq.y = cvtpk(x2[2], x2[3]); bq.z = cvtpk(x2[4], x2[5]); bq.w = cvtpk(x2[6], x2[7]);
            *(LAS v4u*)(KI + img_off(kr, c, 1024)) = a; *(LAS v4u*)(KI + img_off(kr, c + 4, 1024)) = bq; }
#pragma unroll
        for (int i = 0; i < 4; ++i) { const int key = key00 + (F.tid >> 3) + 64 * i; v4u v = (v4u){0u, 0u, 0u, 0u};
            if (key >= 0) v = *(const v4u*)(PROJ + ((size_t)b * SEQ + key) * AB_IN + 640 + kvh * 64 + 8 * (F.tid & 7));
            *(LAS v4u*)(VI + L.wr + 8192 * i) = v; }
        WG_BAR_LDS();
        const int hq = kvh * 4 + g; const float sink2 = sinks[hq] * LOG2E;
#pragma unroll 1
        for (int sbi = 0; sbi < 2; ++sbi) { const int sb = (w & 1) * 2 + sbi, t = 128 * qb + 32 * sb + r32; const size_t tok = (size_t)b * SEQ + t;
            bf16x8 qf[4];
            { const bf16* qp = PROJ + tok * AB_IN + hq * 64 + 8 * h; float x[4][8]; float ss = 0.f;
#pragma unroll
              for (int s = 0; s < 4; ++s) { unpack8(*(const v4u*)(qp + 16 * s), x[s]);
#pragma unroll
                  for (int j = 0; j < 8; ++j) ss += x[s][j] * x[s][j]; }
              ss += __shfl_xor(ss, 32); const float r = (0.125f * LOG2E) / sqrtf(ss * (1.0f / 64) + EPS); const f32x2* tb = ROPE + tok * 32 + 8 * h;
#pragma unroll
              for (int s = 0; s < 2; ++s)
#pragma unroll
                  for (int j = 0; j < 8; ++j) { const f32x2 cs = tb[16 * s + j]; const float y1 = x[s][j] * r * qnorm[16 * s + 8 * h + j], y2 = x[s + 2][j] * r * qnorm[32 + 16 * s + 8 * h + j];
                      x[s][j] = y1 * cs.x - y2 * cs.y; x[s + 2][j] = y2 * cs.x + y1 * cs.y; }
#pragma unroll
              for (int s = 0; s < 4; ++s) { v4u t4; t4.x = cvtpk(x[s][0], x[s][1]); t4.y = cvtpk(x[s][2], x[s][3]); t4.z = cvtpk(x[s][4], x[s][5]); t4.w = cvtpk(x[s][6], x[s][7]); asm volatile("s_nop 1" : "+v"(t4)); qf[s] = __builtin_bit_cast(bf16x8, t4); } }
            f32x16 acc[5]; float mx = sink2;
            const LAS unsigned char* kimg = KI + 4096 * sb; const LAS unsigned char* vimg = VI + 4096 * sb;
#pragma unroll
            for (int j = 0; j < 5; ++j) {
#pragma unroll
                for (int i = 0; i < 16; ++i) acc[j][i] = 0.f;
#pragma unroll
                for (int s = 0; s < 4; ++s) acc[j] = MFMA32(IMG_ROW_READ(kimg, L, j, s), qf[s], acc[j]);
                int rr = r32; asm volatile("" : "+v"(rr)); const bool blk_ok = (key00 + 32 * (sb + j)) >= 0;
#pragma unroll
                for (int i = 0; i < 16; ++i) { const int kap = (i & 3) + 8 * (i >> 2) + 4 * h; const bool valid = blk_ok && (j == 0 ? kap > rr : (j == 4 ? kap <= rr : true));
                    const float v = valid ? acc[j][i] : -3.0e38f; acc[j][i] = v; mx = fmaxf(mx, v); } }
            mx = fmaxf(mx, __shfl_xor(mx, 32)); float l = 0.f;
#pragma unroll
            for (int j = 0; j < 5; ++j)
#pragma unroll
                for (int i = 0; i < 16; ++i) { const float p = __builtin_amdgcn_exp2f(acc[j][i] - mx); acc[j][i] = p; l += p; }
            l += __shfl_xor(l, 32); l += __builtin_amdgcn_exp2f(sink2 - mx); const float linv = 1.0f / l;
            f32x16 o[2];
#pragma unroll
            for (int c = 0; c < 2; ++c) {
#pragma unroll
                for (int i = 0; i < 16; ++i) o[c][i] = 0.f;
#pragma unroll
                for (int j = 0; j < 5; ++j)
#pragma unroll
                    for (int ks = 0; ks < 2; ++ks) { bf16x8 vf; IMG_TR_FRAG_ACC(vf, vimg, L, 32 * j + 16 * ks, c); o[c] = MFMA32(vf, pack_acc(acc[j], ks), o[c]); } }
            bf16* op = AO + tok * DM + hq * 64 + 4 * h;
#pragma unroll
            for (int c = 0; c < 2; ++c)
#pragma unroll
                for (int gg = 0; gg < 4; ++gg) { v2u wv; wv.x = cvtpk(o[c][4 * gg] * linv, o[c][4 * gg + 1] * linv); wv.y = cvtpk(o[c][4 * gg + 2] * linv, o[c][4 * gg + 3] * linv); *(v2u*)(op + 32 * c + 8 * gg) = wv; }
        }
        WG_BAR_LDS();
    }
    WG_BAR();
}
struct Args { const void* in[25]; float* out; unsigned char* ws; };
#if defined(__HIP_DEVICE_COMPILE__)
#define NO_PK_F32 __attribute__((target("no-packed-fp32-ops")))
#else
#define NO_PK_F32
#endif
__global__ void __launch_bounds__(NWAVES * 64, 2) NO_PK_F32 trunk_fwd(Args args) {
    extern __shared__ __attribute__((aligned(16))) unsigned char lds[];
    Frame F;
    F.lds = (LAS unsigned char*)lds; F.MISC = (volatile LAS unsigned*)(F.lds + MISC_OFF);
    F.tid = 0; F.lane = 0; F.gtid = 0; F.gw = 0; F.wave = __builtin_amdgcn_readfirstlane(threadIdx.x >> 6);
    F.G = gridDim.x; { const int bx = blockIdx.x; F.vcu = (F.G % 8 == 0) ? (bx % 8) * (F.G / 8) + bx / 8 : bx; }
    F.NGW = F.G * NWAVES; F.NT = F.G * NWAVES * 64;
    F.ctl = (gu32*)(args.ws + WS_CTL);
    for (int u = threadIdx.x; u < (LDS_BYTES - LDSCTL_OFF) / 4; u += NWAVES * 64) ((LAS unsigned*)(F.lds + LDSCTL_OFF))[u] = 0u;
    asm volatile("s_waitcnt lgkmcnt(0)\n\ts_barrier" ::: "memory");
    XcdBarrier bar = xcd_barrier_post((unsigned*)(F.ctl + CW_BAR), F.MISC + 8);
#define GRID_BAR() xcd_barrier(bar)
    typedef pg8::EpiScaleBf16 ES; typedef pg8::EpiRes ER; typedef pg8::EpiConvGlu EC;
#ifndef REP_G
#define REP_G 1
#endif
#ifndef REP_M
#define REP_M 1
#endif
#ifndef REP_X
#define REP_X 1
#endif
#ifndef REP_H
#define REP_H 1
#endif
#ifndef REP_W
#define REP_W 1
#endif
#ifndef REP_R
#define REP_R 1
#endif
#ifndef REP_SB
#define REP_SB 1
#endif
#ifndef REP_P
#define REP_P 1
#endif
#ifndef REP_C
#define REP_C 1
#endif
#define REPLOOP(n) _Pragma("unroll 1") for (int rep_ = 0; rep_ < (n); ++rep_)
#define RS_LDS ((LAS float*)(F.lds + RING_BYTES + 1024))
#define opq_bx() ({ int bx_ = blockIdx.x; asm volatile("" : "+s"(bx_)); bx_; })
#define opq_g() ({ int g_ = gridDim.x; asm volatile("" : "+s"(g_)); g_; })

#ifndef NO_PRO
    REPLOOP(REP_P) p0_prologue(F);
#endif
    GRID_BAR();
#define WS_BF(off) ((bf16*)(WSP() + (off)))
#define WS_F32(off) ((float*)(WSP() + (off)))
#pragma unroll 1
    for (int l = 0; l < 4; ++l) {
        const int par = l & 1, e = l >> 1;
        { const int N1 = par ? HG_IN : AB_IN; const bf16* Wt = WS_BF(WS_W) + (par ? W_HGIN + (size_t)e * DM * HG_IN : W_ABIN + (size_t)e * DM * AB_IN);
          pg8::Gemm g{WS_BF(WS_XB), Wt, M, N1, DM}; pg8::StaticOrder S; S.init(M, N1, opq_g(), opq_bx()); ES E{WS_BF(WS_BIG), N1, WS_F32(WS_ROWSQ), RS_LDS, par ? nullptr : WS_BF(WS_HM), 5, (size_t)M * 512};
          REPLOOP(REP_G) pg8::gemm_phase<ES, pg8::StaticOrder, true, true>(F.lds, g, S, E); }
        GRID_BAR();
        if (!par) {
#ifdef NAIVE_SWA
            swa_kprep(F, WS_BF(WS_BIG), (const f32x2*)WS_F32(WS_ROPE), INF(I_SWA_K_NORM) + e * 64);
            GRID_BAR();
            swa_naive(F, WS_BF(WS_BIG), WS_BF(WS_AO), (const f32x2*)WS_F32(WS_ROPE), INF(I_SWA_Q_NORM) + e * 64, INF(I_SWA_SINKS) + e * 8);
#else
            REPLOOP(REP_W) swa_mfma(F, WS_BF(WS_BIG), WS_BF(WS_AO), (const f32x2*)WS_F32(WS_ROPE), INF(I_SWA_Q_NORM) + e * 64, INF(I_SWA_K_NORM) + e * 64, INF(I_SWA_SINKS) + e * 8);
#endif
#ifdef NAIVE_SB
            sb_naive(F, WS_BF(WS_BIG), WS_BF(WS_AO));
#else
            REPLOOP(REP_SB) sb_mfma(F, WS_BF(WS_BIG), WS_BF(WS_HM), WS_BF(WS_AO));
#endif
        } else {
#ifdef NAIVE_HGRN
            hgrn_naive(F, WS_BF(WS_BIG), WS_BF(WS_AO), WS_F32(WS_OSQ), WS_F32(WS_LBV) + e * DM);
            GRID_BAR();
            hgrn_post(F, WS_BF(WS_BIG), WS_BF(WS_AO), WS_F32(WS_OSQ), INF(I_HGRN_O_NORM) + e * 128);
#else
            REPLOOP(REP_H) hgrn_mfma(F, WS_BF(WS_BIG), WS_BF(WS_AO), WS_F32(WS_LBV) + e * DM, INF(I_HGRN_O_NORM) + e * 128);
#endif
        }
        GRID_BAR();
        { const bf16* Wt = WS_BF(WS_W) + (par ? W_HGOUT : W_ABOUT) + (size_t)e * DM * DM;
          pg8::Gemm g{WS_BF(WS_AO), Wt, M, DM, DM}; pg8::StaticOrder S; S.init(M, DM, opq_g(), opq_bx()); ER E{nullptr, WS_BF(WS_XB), WS_F32(WS_ROWSQ), false, WS_BF(WS_XB)};
#if REP_R > 1
          { ER Ed{nullptr, WS_BF(WS_XB), WS_F32(WS_OSQ), false, WS_BF(WS_BIG)}; pg8::gemm_phase<ER, pg8::StaticOrder, true, true>(F.lds, g, S, Ed); }
#endif
          pg8::gemm_phase<ER, pg8::StaticOrder, true, true>(F.lds, g, S, E); }
        GRID_BAR();
        { pg8::Gemm g{WS_BF(WS_XB), WS_BF(WS_W) + W_XQ + (size_t)l * DM * DM, M, DM, DM}; pg8::StaticOrder S; S.init(M, DM, opq_g(), opq_bx()); ES E{WS_BF(WS_BIG), DM, WS_F32(WS_ROWSQ), RS_LDS, nullptr, 0, 0};
          REPLOOP(REP_G) pg8::gemm_phase<ES, pg8::StaticOrder, true, true>(F.lds, g, S, E); }
        { pg8::Gemm g{WS_BF(WS_MEMB), WS_BF(WS_W) + W_XKV + (size_t)l * DM * 2 * DM, MM, 2 * DM, DM}; pg8::StaticOrder S; S.init(MM, 2 * DM, opq_g(), opq_bx()); pg8::EpiKV E{WS_BF(WS_KV), 2 * DM, INF(I_XA_Q_NORM) + l * 256, INF(I_XA_K_NORM) + l * 256, RS_LDS};
          REPLOOP(REP_G) pg8::gemm_phase<pg8::EpiKV, pg8::StaticOrder, true, true>(F.lds, g, S, E); }
        GRID_BAR();
#ifdef NAIVE_CROSS
        cross_naive(F, WS_BF(WS_BIG), WS_BF(WS_KV), WS_BF(WS_AO), INF(I_XA_Q_NORM) + l * 256, INF(I_XA_K_NORM) + l * 256);
#else
        REPLOOP(REP_X) cross_mfma(F, WS_BF(WS_BIG), WS_BF(WS_KV), WS_BF(WS_AO), INF(I_XA_Q_NORM) + l * 256, INF(I_XA_K_NORM) + l * 256);
#endif
        GRID_BAR();
        { pg8::Gemm g{WS_BF(WS_AO), WS_BF(WS_W) + W_XO + (size_t)l * DM * DM, M, DM, DM}; pg8::StaticOrder S; S.init(M, DM, opq_g(), opq_bx()); ER E{nullptr, WS_BF(WS_XB), WS_F32(WS_ROWSQ), false, WS_BF(WS_XB)};
#if REP_R > 1
          { ER Ed{nullptr, WS_BF(WS_XB), WS_F32(WS_OSQ), false, WS_BF(WS_BIG)}; pg8::gemm_phase<ER, pg8::StaticOrder, true, true>(F.lds, g, S, Ed); }
#endif
          pg8::gemm_phase<ER, pg8::StaticOrder, true, true>(F.lds, g, S, E); }
        GRID_BAR();
        { pg8::Gemm g{WS_BF(WS_XB), WS_BF(WS_W) + W_UP + (size_t)l * DM * UPN, M, UPN, DM}; pg8::StaticOrder S; S.init(M, UPN, opq_g(), opq_bx());
          EC E{WS_BF(WS_ACT), WS_F32(WS_ROWSQ), INF(I_FFN_CONV_W) + (size_t)l * 3 * UPN, INF(I_FFN_CONV_B) + (size_t)l * UPN, WS_F32(WS_EDGE), RS_LDS};
          REPLOOP(REP_G) pg8::gemm_phase<EC, pg8::StaticOrder, true, true, true>(F.lds, g, S, E); }
        GRID_BAR();
        ffn_fix(F, WS_F32(WS_EDGE), WS_BF(WS_ACT), INF(I_FFN_CONV_W) + (size_t)l * 3 * UPN, INF(I_FFN_CONV_B) + (size_t)l * UPN);
        GRID_BAR();
        { pg8::Gemm g{WS_BF(WS_ACT), WS_BF(WS_W) + W_DOWN + (size_t)l * DFF * DM, M, DM, DFF}; pg8::StaticOrder S; S.init(M, DM, opq_g(), opq_bx()); ER E{OUTP(), WS_BF(WS_XB), WS_F32(WS_ROWSQ), l == 3, WS_BF(WS_XB)};
#if REP_R > 1
          { ER Ed{nullptr, WS_BF(WS_XB), WS_F32(WS_OSQ), false, WS_BF(WS_AO)}; pg8::gemm_phase<ER, pg8::StaticOrder, true, true>(F.lds, g, S, Ed); }
#endif
          pg8::gemm_phase<ER, pg8::StaticOrder, true, true>(F.lds, g, S, E); }
        GRID_BAR();
    }
}

extern "C" void kernel_launch(void* const* d_in, const int* in_sizes, int n_in, void* d_out, int out_size, void* d_ws, size_t ws_size, hipStream_t stream) {
    static int grid = 0;
    if (grid == 0) {
        if (n_in != 25 || in_sizes[0] != M * DM || out_size != M * DM || ws_size < WS_END) { fprintf(stderr, "kernel_launch: unexpected shapes / workspace (n_in %d, in0 %d, out %d, ws %zu < %zu); nothing launched\n", n_in, n_in > 0 ? in_sizes[0] : -1, out_size, ws_size, (size_t)WS_END); grid = -1; return; }
        int dev = 0, cus = 0, per_cu = 0;
        if (hipGetDevice(&dev) != hipSuccess || hipDeviceGetAttribute(&cus, hipDeviceAttributeMultiprocessorCount, dev) != hipSuccess) { grid = -1; return; }
        if (hipFuncSetAttribute((const void*)trunk_fwd, hipFuncAttributeMaxDynamicSharedMemorySize, LDS_BYTES) != hipSuccess) { fprintf(stderr, "kernel_launch: hipFuncSetAttribute failed\n"); grid = -1; return; }
        if (hipOccupancyMaxActiveBlocksPerMultiprocessor(&per_cu, (const void*)trunk_fwd, NWAVES * 64, LDS_BYTES) != hipSuccess || per_cu < 1) fprintf(stderr, "kernel_launch: note: occupancy query reports %d\n", per_cu);
        (void)hipGetLastError();
        grid = cus;
    }
    if (grid < 0) return;
    if (hipMemsetAsync((char*)d_ws + WS_CTL, 0, CTL_ZERO_BYTES, stream) != hipSuccess) return;
    Args a{};
    for (int i = 0; i < 25; ++i) a.in[i] = d_in[i];
    a.out = (float*)d_out; a.ws = (unsigned char*)d_ws;
    hipLaunchKernelGGL(trunk_fwd, dim3(grid), dim3(NWAVES * 64), LDS_BYTES, stream, a);
}
```

```cpp
#include <hip/hip_runtime.h>
#include <cstdio>
#include <cstdint>
#include <cmath>
namespace pg8 {
#define PG8_LAS __attribute__((address_space(3)))
typedef unsigned short bf16_t;
typedef short bf16x8 __attribute__((ext_vector_type(8)));
typedef float f32x4 __attribute__((ext_vector_type(4)));
typedef unsigned u32x4 __attribute__((ext_vector_type(4)));
constexpr int BM = 256, BK = 64, HALF = 128, HTB = HALF * BK * 2  , STAGE_BYTES = 8 * HTB, NXCD = 8, WGM = 8;

__host__ __device__ __forceinline__ int lds_byte(int r, int c) { const int st = (r >> 4) * 2 + (c >> 5), rr = r & 15, cc = c & 31, ob = rr * 64 + cc * 2; return st * 1024 + (ob ^ (((ob >> 9) & 1) << 5)); }
__host__ __device__ __forceinline__ void stage_rc(int b, int& R, int& C) { const int st = b / 1024, sb = b % 1024, swz = sb ^ (((sb >> 9) & 1) << 5); R = (st >> 1) * 16 + swz / 64; C = (st & 1) * 32 + (swz % 64) / 2; }
__host__ __device__ __forceinline__ int perm32(int rho) { const int n = rho >> 4, i = rho & 15; return 8 * (i >> 2) + 4 * n + (i & 3); }

struct Unit { int pm, pn; };
struct Gemm { const bf16_t* A; const bf16_t* Bt; int M, N, K; };

struct StaticOrder {
    int nM, nN, nwg, G, c;
    __host__ __device__ __forceinline__ void init(int M, int N, int G_, int c_) { nM = M / BM; nN = N / BM; nwg = nM * nN; G = G_; c = c_; }
    __host__ __device__ __forceinline__ bool next(int i, Unit& u) const {
        const long L = (long)i * G + c; if (L >= nwg) return false;
        int wgid = (int)L; { const int q = nwg / NXCD, r = nwg % NXCD, xcd = wgid % NXCD, off = wgid / NXCD; wgid = (xcd < r ? xcd * (q + 1) : r * (q + 1) + (xcd - r) * q) + off; }
        const int nig = WGM * nN, gid = wgid / nig, fm = gid * WGM, gsz = (nM - fm) < WGM ? (nM - fm) : WGM;
        u.pm = fm + ((wgid % nig) % gsz); u.pn = (wgid % nig) / gsz; return true;
    }
    __device__ __forceinline__ void a_ready(const Unit&) const {}
    __device__ __forceinline__ void done(const Unit&) const {}
};

__device__ __forceinline__ unsigned cvt_pk_bf16(float lo, float hi) { unsigned r; asm volatile("v_cvt_pk_bf16_f32 %0, %1, %2" : "=v"(r) : "v"(lo), "v"(hi)); return r; }
typedef float f32x2 __attribute__((ext_vector_type(2)));

__device__ __forceinline__ void unit_rstd(PG8_LAS float* rs, const float* rowsq, int pm) {
    int t = threadIdx.x; asm volatile("" : "+v"(t));
    if (t < 256) { const f32x4* rp = (const f32x4*)(rowsq + (size_t)(pm * BM + t) * 16); const f32x4 a = rp[0], b = rp[1], c = rp[2], d = rp[3];
        const float s = ((a[0] + a[1]) + (a[2] + a[3])) + ((b[0] + b[1]) + (b[2] + b[3])) + ((c[0] + c[1]) + (c[2] + c[3])) + ((d[0] + d[1]) + (d[2] + d[3]));
        rs[t] = 1.0f / sqrtf(s * (1.0f / 1024.0f) + 1e-6f); }
    asm volatile("s_waitcnt lgkmcnt(0)\n\ts_barrier" ::: "memory");
}

__device__ __forceinline__ void unit_rstd_conv(PG8_LAS float* rs, const float* rowsq, int pm, PG8_LAS float* ct, const float* cw, const float* cb, int pn) {
    int t = threadIdx.x; asm volatile("" : "+v"(t));
    if (t < 256) { const f32x4* rp = (const f32x4*)(rowsq + (size_t)(pm * BM + t) * 16); const f32x4 a = rp[0], b = rp[1], c = rp[2], d = rp[3];
        const float s = ((a[0] + a[1]) + (a[2] + a[3])) + ((b[0] + b[1]) + (b[2] + b[3])) + ((c[0] + c[1]) + (c[2] + c[3])) + ((d[0] + d[1]) + (d[2] + d[3]));
        rs[t] = 1.0f / sqrtf(s * (1.0f / 1024.0f) + 1e-6f); }
    else { const int j = t - 256, p = j >> 5, c4 = (j & 31) * 4; const float* srcp = ((p & 3) < 3 ? cw + (p & 3) * 5632 : cb) + (p >> 2) * 2816 + pn * 128 + c4;
        const float k = (p >> 2) ? 0.6931471805599453f : 1.4426950408889634f;
        *(PG8_LAS f32x4*)(ct + p * 128 + c4) = *(const f32x4*)srcp * k; }
    asm volatile("s_waitcnt lgkmcnt(0)\n\ts_barrier" ::: "memory");
}

struct EpiScaleBf16 {
    static constexpr bool PERM = true, AFTER_DRAIN = false;
    bf16_t* O; int ldc; const float* rowsq; PG8_LAS float* rs;
    bf16_t* HM; int hm_pn0; size_t hm_stride;
    __device__ __forceinline__ void operator()(const f32x4 (&acc)[2][2][4][2], const Unit& u, int wr, int wc, int fr, int fq) const {
        if (rowsq) unit_rstd(rs, rowsq, u.pm);
        const bool hm = HM != nullptr && u.pn >= hm_pn0; const int q = u.pn - hm_pn0;
        const unsigned vo = 2u * (hm ? (unsigned)((((wc >> 1) * 2048 + wr * 64 + fr) * 64) + 32 * (wc & 1) + 8 * fq) : (unsigned)((wr * 64 + fr) * ldc + wc * 32 + 8 * fq));
#pragma unroll
        for (int ai = 0; ai < 2; ++ai)
#pragma unroll
            for (int m = 0; m < 4; ++m) { float sc = 1.f;
                if (rowsq) sc = rs[wr * 64 + fr + ai * HALF + m * 16];
#pragma unroll
                for (int bj = 0; bj < 2; ++bj) { const f32x4 v0 = acc[ai][bj][m][0] * sc, v1 = acc[ai][bj][m][1] * sc;
                    u32x4 w; w.x = cvt_pk_bf16(v0[0], v0[1]); w.y = cvt_pk_bf16(v0[2], v0[3]); w.z = cvt_pk_bf16(v1[0], v1[1]); w.w = cvt_pk_bf16(v1[2], v1[3]);
                    const bf16_t* ob = O + (size_t)(u.pm * BM + ai * HALF + m * 16) * ldc + u.pn * BM + bj * HALF;
                    const bf16_t* hb = HM + (size_t)(q >> 1) * hm_stride + (size_t)((((u.pm >> 3) * 8 + (q & 1) * 4 + 2 * bj) * 2048) + (u.pm & 7) * 256 + ai * HALF + m * 16) * 64;
                    *(u32x4*)((char*)(hm ? hb : ob) + vo) = w; } }
    }
};
struct EpiKV {
    static constexpr bool PERM = true, AFTER_DRAIN = false;
    bf16_t* O; int ldc; const float* gq; const float* gk; PG8_LAS float* rs;
    __device__ __forceinline__ void operator()(const f32x4 (&acc)[2][2][4][2], const Unit& u, int wr, int wc, int fr, int fq) const {
        const int row0 = u.pm * BM + wr * 64 + fr; const int col0 = u.pn * BM + wc * 32 + 8 * fq; const bool isk = u.pn < 4;
        float sc[2][4]; f32x4 g[2][2];
#pragma unroll
        for (int ai = 0; ai < 2; ++ai)
#pragma unroll
            for (int m = 0; m < 4; ++m) sc[ai][m] = 1.f;
#pragma unroll
        for (int bj = 0; bj < 2; ++bj)
#pragma unroll
            for (int n = 0; n < 2; ++n) g[bj][n] = (f32x4){1.f, 1.f, 1.f, 1.f};
        if (isk) { PG8_LAS float* part = rs + 256;
#pragma unroll
            for (int ai = 0; ai < 2; ++ai)
#pragma unroll
                for (int m = 0; m < 4; ++m) { float s = 0.f;
#pragma unroll
                    for (int bj = 0; bj < 2; ++bj)
#pragma unroll
                        for (int n = 0; n < 2; ++n)
#pragma unroll
                            for (int i = 0; i < 4; ++i) s = __builtin_fmaf(acc[ai][bj][m][n][i], acc[ai][bj][m][n][i], s);
                    s += __shfl_xor(s, 16); s += __shfl_xor(s, 32);
                    if (fq == 0) part[wc * 256 + wr * 64 + fr + ai * HALF + m * 16] = s; }
            asm volatile("s_waitcnt lgkmcnt(0)\n\ts_barrier" ::: "memory");
            { int t = threadIdx.x; asm volatile("" : "+v"(t));
              if (t < 256) rs[t] = 1.0f / sqrtf(((part[t] + part[256 + t]) + (part[512 + t] + part[768 + t])) * (1.0f / 256.0f) + 1e-6f); }
            asm volatile("s_waitcnt lgkmcnt(0)\n\ts_barrier" ::: "memory");
#pragma unroll
            for (int ai = 0; ai < 2; ++ai)
#pragma unroll
                for (int m = 0; m < 4; ++m) sc[ai][m] = rs[wr * 64 + fr + ai * HALF + m * 16];
#pragma unroll
            for (int bj = 0; bj < 2; ++bj)
#pragma unroll
                for (int n = 0; n < 2; ++n) { const int c = bj * HALF + wc * 32 + 8 * fq + 4 * n; g[bj][n] = *(const f32x4*)(gq + c) * *(const f32x4*)(gk + c); } }
#pragma unroll
        for (int ai = 0; ai < 2; ++ai)
#pragma unroll
            for (int m = 0; m < 4; ++m) { const int row = row0 + ai * HALF + m * 16; bf16_t* rowp = O + (size_t)row * ldc + col0;
#pragma unroll
                for (int bj = 0; bj < 2; ++bj) { const f32x4 v0 = acc[ai][bj][m][0] * g[bj][0] * sc[ai][m], v1 = acc[ai][bj][m][1] * g[bj][1] * sc[ai][m];
                    u32x4 w; w.x = cvt_pk_bf16(v0[0], v0[1]); w.y = cvt_pk_bf16(v0[2], v0[3]); w.z = cvt_pk_bf16(v1[0], v1[1]); w.w = cvt_pk_bf16(v1[2], v1[3]);
                    *(u32x4*)(rowp + bj * HALF) = w; } }
    }
};
struct EpiRes {
    static constexpr bool PERM = true, AFTER_DRAIN = false;
    float* out; bf16_t* xb; float* rowsq; bool fin; bf16_t* xbw;
    __device__ __forceinline__ void operator()(const f32x4 (&acc)[2][2][4][2], const Unit& u, int wr, int wc, int fr, int fq) const {
        const unsigned lv = (unsigned)((wr * 64 + fr) * 1024 + wc * 32 + 8 * fq);
#define UB(ai_, m_, bj_) ((size_t)(u.pm * BM + (ai_) * HALF + (m_) * 16) * 1024 + u.pn * BM + (bj_) * HALF)
        u32x4 xv[2][4][2];
#pragma unroll
        for (int ai = 0; ai < 2; ++ai)
#pragma unroll
            for (int m = 0; m < 4; ++m)
#pragma unroll
                for (int bj = 0; bj < 2; ++bj) xv[ai][m][bj] = *(const u32x4*)((const char*)(xb + UB(ai, m, bj)) + 2u * lv);
#pragma unroll
        for (int ai = 0; ai < 2; ++ai)
#pragma unroll
            for (int m = 0; m < 4; ++m) { float s = 0.f;
#pragma unroll
                for (int bj = 0; bj < 2; ++bj) { const u32x4 b = xv[ai][m][bj];
                    f32x4 o0 = acc[ai][bj][m][0], o1 = acc[ai][bj][m][1];
                    o0[0] += __uint_as_float(b.x << 16); o0[1] += __uint_as_float(b.x & 0xffff0000u); o0[2] += __uint_as_float(b.y << 16); o0[3] += __uint_as_float(b.y & 0xffff0000u);
                    o1[0] += __uint_as_float(b.z << 16); o1[1] += __uint_as_float(b.z & 0xffff0000u); o1[2] += __uint_as_float(b.w << 16); o1[3] += __uint_as_float(b.w & 0xffff0000u);
                    if (fin) { char* op_ = (char*)(out + UB(ai, m, bj)) + 4u * lv; *(f32x4*)op_ = o0; *(f32x4*)(op_ + 16) = o1; }
                    else { u32x4 w; w.x = cvt_pk_bf16(o0[0], o0[1]); w.y = cvt_pk_bf16(o0[2], o0[3]); w.z = cvt_pk_bf16(o1[0], o1[1]); w.w = cvt_pk_bf16(o1[2], o1[3]); *(u32x4*)((char*)(xbw + UB(ai, m, bj)) + 2u * lv) = w; }
#pragma unroll
                    for (int i = 0; i < 4; ++i) s = __builtin_fmaf(o0[i], o0[i], s);
#pragma unroll
                    for (int i = 0; i < 4; ++i) s = __builtin_fmaf(o1[i], o1[i], s); }
                s += __shfl_xor(s, 16); s += __shfl_xor(s, 32);
                if (fq == 0) *(float*)((char*)(rowsq + (size_t)(u.pm * BM + ai * HALF + m * 16) * 16 + u.pn * 4) + 4u * (unsigned)((wr * 64 + fr) * 16 + wc)) = s; }
    }
#undef UB
};

struct EpiConvGlu {
    static constexpr bool PERM = true, AFTER_DRAIN = false;
    bf16_t* ACT; const float* rowsq; const float* cw; const float* cb; float* EDGE; PG8_LAS float* rs;
    static __device__ __forceinline__ f32x4 shr1(const f32x4 v) { float r0, r1, r2, r3;
        asm volatile("s_nop 4\n\tv_mov_b32_dpp %0, %4 row_shr:1 row_mask:0xf bank_mask:0xf bound_ctrl:1\n\tv_mov_b32_dpp %1, %5 row_shr:1 row_mask:0xf bank_mask:0xf bound_ctrl:1\n\t"
                     "v_mov_b32_dpp %2, %6 row_shr:1 row_mask:0xf bank_mask:0xf bound_ctrl:1\n\tv_mov_b32_dpp %3, %7 row_shr:1 row_mask:0xf bank_mask:0xf bound_ctrl:1"
                     : "=&v"(r0), "=&v"(r1), "=&v"(r2), "=&v"(r3) : "v"(v[0]), "v"(v[1]), "v"(v[2]), "v"(v[3]));
        return (f32x4){r0, r1, r2, r3}; }
    __device__ __forceinline__ void operator()(f32x4 (&acc)[2][2][4][2], const Unit& u, int wr, int wc, int fr, int fq) const {
        const unsigned alv = (unsigned)(8 * (fr + 16 * wr) * 2816 + wc * 32 + 8 * fq);
        PG8_LAS float* ct = rs + 256; unit_rstd_conv(rs, rowsq, u.pm, ct, cw, cb, u.pn); const int cl = wc * 32 + 8 * fq;
        const f32x4 sc0 = *(const PG8_LAS f32x4*)(rs + 8 * (fr + 16 * wr)), sc1 = *(const PG8_LAS f32x4*)(rs + 8 * (fr + 16 * wr) + 4);
#pragma unroll
        for (int ai = 0; ai < 2; ++ai)
#pragma unroll
            for (int m = 0; m < 4; ++m) { const float sc = ai ? sc1[m] : sc0[m];
#pragma unroll
                for (int bj = 0; bj < 2; ++bj)
#pragma unroll
                    for (int n = 0; n < 2; ++n) acc[ai][bj][m][n] = acc[ai][bj][m][n] * sc; }
        { const unsigned elv = 4u * (unsigned)(wr * 4 * 5632 + wc * 32 + 8 * fq); float* const eu = EDGE + (size_t)(2 * u.pm) * 4 * 5632 + u.pn * BM;
#define ep_at(o_) ((char*)(eu + (o_)) + elv)
          if (fr == 0) {
#pragma unroll
              for (int bj = 0; bj < 2; ++bj)
#pragma unroll
                  for (int n = 0; n < 2; ++n) { *(f32x4*)ep_at(bj * HALF + 4 * n) = acc[0][bj][0][n]; *(f32x4*)ep_at(5632 + bj * HALF + 4 * n) = acc[0][bj][1][n]; }
              asm volatile("; strip-head rows stored" ::: "memory"); }
          if (fr == 15) {
#pragma unroll
              for (int bj = 0; bj < 2; ++bj)
#pragma unroll
                  for (int n = 0; n < 2; ++n) { *(f32x4*)ep_at(2 * 5632 + bj * HALF + 4 * n) = acc[1][bj][2][n]; *(f32x4*)ep_at(3 * 5632 + bj * HALF + 4 * n) = acc[1][bj][3][n]; }
              asm volatile("; strip-tail rows stored" ::: "memory"); } }
#undef ep_at
#pragma unroll
        for (int n = 0; n < 2; ++n) { asm volatile("" ::: "memory");
            const PG8_LAS float* cp = ct + cl + 4 * n;
            const f32x4 g0 = *(const PG8_LAS f32x4*)(cp), g1 = *(const PG8_LAS f32x4*)(cp + 128), g2 = *(const PG8_LAS f32x4*)(cp + 256), gb = *(const PG8_LAS f32x4*)(cp + 384);
            const f32x4 u0 = *(const PG8_LAS f32x4*)(cp + 512), u1 = *(const PG8_LAS f32x4*)(cp + 640), u2 = *(const PG8_LAS f32x4*)(cp + 768), ub = *(const PG8_LAS f32x4*)(cp + 896);
            const f32x4 gh1 = shr1(acc[1][0][3][n]), gh2 = shr1(acc[1][0][2][n]), uh1 = shr1(acc[1][1][3][n]), uh2 = shr1(acc[1][1][2][n]);
#pragma unroll
            for (int k = 0; k < 8; ++k) { const f32x4 gv = acc[k >> 2][0][k & 3][n], uv = acc[k >> 2][1][k & 3][n];
                const f32x4 gm1 = (k >= 1) ? acc[(k - 1) >> 2][0][(k - 1) & 3][n] : gh1, um1 = (k >= 1) ? acc[(k - 1) >> 2][1][(k - 1) & 3][n] : uh1;
                const f32x4 gm2 = (k >= 2) ? acc[(k - 2) >> 2][0][(k - 2) & 3][n] : (k == 1 ? gh1 : gh2), um2 = (k >= 2) ? acc[(k - 2) >> 2][1][(k - 2) & 3][n] : (k == 1 ? uh1 : uh2);
                f32x4 gg, uu, a, e;
#pragma unroll
                for (int i = 0; i < 4; ++i) { gg[i] = __builtin_fmaf(g2[i], gv[i], __builtin_fmaf(g1[i], gm1[i], __builtin_fmaf(g0[i], gm2[i], gb[i]))); uu[i] = __builtin_fmaf(u2[i], uv[i], __builtin_fmaf(u1[i], um1[i], __builtin_fmaf(u0[i], um2[i], ub[i]))); }
#pragma unroll
                for (int i = 0; i < 4; ++i) e[i] = __builtin_amdgcn_exp2f(-gg[i]);
#pragma unroll
                for (int i = 0; i < 4; ++i) { e[i] = 1.0f + e[i]; uu[i] *= gg[i]; }
#pragma unroll
                for (int i = 0; i < 4; ++i) e[i] = __builtin_amdgcn_rcpf(e[i]);
#pragma unroll
                for (int i = 0; i < 4; ++i) a[i] = uu[i] * e[i];
                typedef unsigned u32x2v __attribute__((ext_vector_type(2))); u32x2v w; w.x = cvt_pk_bf16(a[0], a[1]); w.y = cvt_pk_bf16(a[2], a[3]);
                *(u32x2v*)((char*)(ACT + (size_t)(u.pm * BM + k) * 2816 + u.pn * 128 + 4 * n) + 2u * alv) = w; } }
    }
};

template <class Epi, class Sched, bool ALIGN_EPI = false, bool SP2 = false, bool APERM = false>
__device__ __forceinline__ void gemm_phase(PG8_LAS unsigned char* lds, const Gemm g, const Sched& S, const Epi& E) {
    int tid_ = threadIdx.x; asm volatile("" : "+v"(tid_));
    const int tid = tid_, wid = __builtin_amdgcn_readfirstlane(tid >> 6), lane = tid & 63, wr = wid >> 2, wc = wid & 3, fr = lane & 15, fq = lane >> 4;
    const int K = g.K, nt = K / BK;
    unsigned voffA[2], voffB[2];
#pragma unroll
    for (int i = 0; i < 2; ++i) { int R, C; stage_rc(tid * 16 + i * 8192, R, C); const int Rb = Epi::PERM ? ((R & ~31) + perm32(R & 31)) : R;
        const int Ra = APERM ? (8 * ((R & 15) + 16 * ((R >> 6) & 1)) + ((R >> 4) & 3)) : R; voffA[i] = (unsigned)(Ra * K + C) * 2u; voffB[i] = (unsigned)(Rb * K + C) * 2u; }
    const size_t kstep = (size_t)(BK * 2);
    const size_t hstep = (size_t)HALF * K * 2;
    const size_t hstepA = APERM ? (size_t)4 * K * 2 : hstep;
    const size_t tstep = 2 * hstep;
    const unsigned ldsw = (unsigned)wid * 1024u;
    const int aoff = lds_byte(wr * 64 + fr, fq * 8), boff = lds_byte(wc * 32 + fr, fq * 8);
#define PG8_SA(b, h) (((b) * 2 + (h)) * HTB)
#define PG8_SB(b, h) ((4 + (b) * 2 + (h)) * HTB)
#define PG8_STAGE(bufoff, gbase, voff) do { _Pragma("unroll") for (int _i = 0; _i < 2; ++_i) \
        __builtin_amdgcn_global_load_lds((const unsigned*)((const char*)(gbase) + (voff)[_i]), (PG8_LAS unsigned*)(lds + (bufoff) + ldsw + _i * 8192), 16, 0, 0); } while (0)
#define PG8_LDA(dst, b, h) do { _Pragma("unroll") for (int m = 0; m < 4; ++m) _Pragma("unroll") for (int k = 0; k < 2; ++k) dst[m][k] = *(const PG8_LAS bf16x8*)(lds + PG8_SA(b, h) + aoff + m * 2048 + k * 1024); } while (0)
#define PG8_LDB(dst, b, h) do { _Pragma("unroll") for (int n = 0; n < 2; ++n) _Pragma("unroll") for (int k = 0; k < 2; ++k) dst[n][k] = *(const PG8_LAS bf16x8*)(lds + PG8_SB(b, h) + boff + n * 2048 + k * 1024); } while (0)
#define PG8_MMA_BODY(ai, bj, At, Bt) _Pragma("unroll") for (int m = 0; m < 4; ++m) _Pragma("unroll") for (int q = 0; q < 4; ++q) { const int e = (m & 1) ? 3 - q : q, n = e >> 1, k = (e & 1) ^ (e >> 1); \
        acc[ai][bj][m][n] = __builtin_amdgcn_mfma_f32_16x16x32_bf16(Bt[n][k], At[m][k], acc[ai][bj][m][n], 0, 0, 0); __builtin_amdgcn_sched_barrier(0); }
#define PG8_MMAR_BODY(ai, bj, At, Bt) _Pragma("unroll") for (int mi = 0; mi < 4; ++mi) _Pragma("unroll") for (int q = 0; q < 4; ++q) { const int m = 3 - mi, e = (mi & 1) ? 3 - q : q, n = e >> 1, k = (e & 1) ^ (e >> 1); \
        acc[ai][bj][m][n] = __builtin_amdgcn_mfma_f32_16x16x32_bf16(Bt[n][k], At[m][k], acc[ai][bj][m][n], 0, 0, 0); __builtin_amdgcn_sched_barrier(0); }
#define PG8_MMA(ai, bj, At, Bt) do { __builtin_amdgcn_s_setprio(1); PG8_MMA_BODY(ai, bj, At, Bt) __builtin_amdgcn_s_setprio(0); } while (0)
#define PG8_MMAR(ai, bj, At, Bt) do { __builtin_amdgcn_s_setprio(1); PG8_MMAR_BODY(ai, bj, At, Bt) __builtin_amdgcn_s_setprio(0); } while (0)
#define PG8_MMA2(ai, At, Ba, Bb) do { __builtin_amdgcn_s_setprio(1); PG8_MMA_BODY(ai, 0, At, Ba) PG8_MMAR_BODY(ai, 1, At, Bb) __builtin_amdgcn_s_setprio(0); } while (0)
#define PG8_WAIT_V(n) asm volatile("s_waitcnt vmcnt(" #n ")" ::: "memory")
#define PG8_WAIT_L(n) asm volatile("s_waitcnt lgkmcnt(" #n ")" ::: "memory")
#define PG8_BAR __builtin_amdgcn_s_barrier()
#define PG8_SCHED __builtin_amdgcn_sched_barrier(0)
    Unit cur, nxt; int ui = 0;
    if (!S.next(0, cur)) return;
    f32x4 acc[2][2][4][2];
#pragma unroll
    for (int a = 0; a < 2; ++a)
#pragma unroll
        for (int b = 0; b < 2; ++b)
#pragma unroll
            for (int m = 0; m < 4; ++m)
#pragma unroll
                for (int n = 0; n < 2; ++n) acc[a][b][m][n] = (f32x4){0.f, 0.f, 0.f, 0.f};
    bf16x8 At[4][2], B0[2][2], B1[2][2];
    const char* cA = (const char*)g.A + (size_t)cur.pm * tstep; const char* cB = (const char*)g.Bt + (size_t)cur.pn * tstep;
    S.a_ready(cur);
    if constexpr (SP2) {
        PG8_STAGE(PG8_SB(0, 0), cB, voffB); PG8_STAGE(PG8_SB(0, 1), cB + hstep, voffB); PG8_STAGE(PG8_SA(0, 0), cA, voffA); PG8_STAGE(PG8_SA(0, 1), cA + hstepA, voffA);
        if (wr == 1) PG8_BAR;
        PG8_WAIT_V(2); PG8_BAR;
        PG8_STAGE(PG8_SB(1, 0), cB + kstep, voffB); PG8_STAGE(PG8_SA(1, 0), cA + kstep, voffA); PG8_STAGE(PG8_SB(1, 1), cB + hstep + kstep, voffB);
        PG8_WAIT_V(6); PG8_BAR;
    } else {
        PG8_STAGE(PG8_SB(0, 0), cB, voffB); PG8_STAGE(PG8_SA(0, 0), cA, voffA); PG8_STAGE(PG8_SB(0, 1), cB + hstep, voffB); PG8_STAGE(PG8_SA(0, 1), cA + hstepA, voffA);
        if (wr == 1) PG8_BAR;
        PG8_WAIT_V(4); PG8_BAR;
        PG8_STAGE(PG8_SB(1, 0), cB + kstep, voffB); PG8_STAGE(PG8_SA(1, 0), cA + kstep, voffA); PG8_STAGE(PG8_SB(1, 1), cB + hstep + kstep, voffB);
        PG8_WAIT_V(6); PG8_BAR;
    }
    for (;;) {
        const bool has_next = S.next(ui + 1, nxt);
        const char* nA = has_next ? (const char*)g.A + (size_t)nxt.pm * tstep : cA; const char* nB = has_next ? (const char*)g.Bt + (size_t)nxt.pn * tstep : cB;
        for (int t = 0; t < nt; t += 2) {
            const bool last = (t == nt - 2);
            const char* a1 = cA + (size_t)(t + 1) * kstep;
            const char* a2 = last ? nA : cA + (size_t)(t + 2) * kstep; const char* b2 = last ? nB : cB + (size_t)(t + 2) * kstep;
            const char* a3 = a2 + kstep; const char* b3 = b2 + kstep;
            if (last && has_next) S.a_ready(nxt);
            if constexpr (SP2) {
            PG8_LDB(B0, 0, 0); PG8_LDB(B1, 0, 1); PG8_SCHED; PG8_LDA(At, 0, 0); PG8_STAGE(PG8_SA(1, 1), a1 + hstepA, voffA);
            PG8_WAIT_V(8); PG8_WAIT_L(0); PG8_BAR; PG8_MMA2(0, At, B0, B1); PG8_BAR; PG8_SCHED;
            PG8_LDA(At, 0, 1); PG8_STAGE(PG8_SB(0, 0), b2, voffB); PG8_STAGE(PG8_SB(0, 1), b2 + hstep, voffB); PG8_STAGE(PG8_SA(0, 0), a2, voffA);
            PG8_WAIT_V(8); PG8_WAIT_L(0); PG8_BAR; PG8_MMA2(1, At, B0, B1); PG8_BAR; PG8_SCHED;
            PG8_LDB(B0, 1, 0); PG8_LDB(B1, 1, 1); PG8_SCHED; PG8_LDA(At, 1, 0); PG8_STAGE(PG8_SA(0, 1), a2 + hstepA, voffA);
            PG8_WAIT_V(8); PG8_WAIT_L(0); PG8_BAR; PG8_MMA2(0, At, B0, B1); PG8_BAR; PG8_SCHED;
            PG8_LDA(At, 1, 1); PG8_STAGE(PG8_SB(1, 0), b3, voffB); PG8_STAGE(PG8_SB(1, 1), b3 + hstep, voffB); PG8_STAGE(PG8_SA(1, 0), a3, voffA);
            PG8_WAIT_V(8); PG8_WAIT_L(0); PG8_BAR; PG8_MMA2(1, At, B0, B1); PG8_BAR; PG8_SCHED;
            } else {
            PG8_LDB(B0, 0, 0); PG8_SCHED; PG8_LDA(At, 0, 0); PG8_STAGE(PG8_SA(1, 1), a1 + hstepA, voffA);
            PG8_WAIT_L(8); PG8_BAR; PG8_WAIT_L(0); PG8_MMA(0, 0, At, B0); PG8_BAR; PG8_SCHED;
            PG8_LDB(B1, 0, 1); PG8_STAGE(PG8_SB(0, 0), b2, voffB);
            PG8_BAR; PG8_WAIT_L(0); PG8_MMA(0, 1, At, B1); PG8_BAR;
            PG8_LDA(At, 0, 1); PG8_STAGE(PG8_SA(0, 0), a2, voffA);
            PG8_BAR; PG8_WAIT_L(0); PG8_MMA(1, 0, At, B0); PG8_BAR; PG8_SCHED;
            PG8_STAGE(PG8_SB(0, 1), b2 + hstep, voffB);
            PG8_WAIT_V(6); PG8_BAR; PG8_MMA(1, 1, At, B1); PG8_BAR;
            PG8_LDB(B0, 1, 0); PG8_SCHED; PG8_LDA(At, 1, 0); PG8_STAGE(PG8_SA(0, 1), a2 + hstepA, voffA);
            PG8_WAIT_L(8); PG8_BAR; PG8_WAIT_L(0); PG8_MMA(0, 0, At, B0); PG8_BAR; PG8_SCHED;
            PG8_LDB(B1, 1, 1); PG8_STAGE(PG8_SB(1, 0), b3, voffB);
            PG8_BAR; PG8_WAIT_L(0); PG8_MMA(0, 1, At, B1); PG8_BAR;
            PG8_LDA(At, 1, 1); PG8_STAGE(PG8_SA(1, 0), a3, voffA);
            PG8_BAR; PG8_WAIT_L(0); PG8_MMA(1, 0, At, B0); PG8_BAR; PG8_SCHED;
            PG8_STAGE(PG8_SB(1, 1), b3 + hstep, voffB);
            PG8_WAIT_V(6); PG8_BAR; PG8_MMA(1, 1, At, B1); PG8_BAR;
            }
        }
        if constexpr (ALIGN_EPI) { if (wr == 0) PG8_BAR; }
        if constexpr (!Epi::AFTER_DRAIN) { E(acc, cur, wr, wc, fr, fq); S.done(cur); }
        if (!has_next) break;
#pragma unroll
        for (int a = 0; a < 2; ++a)
#pragma unroll
            for (int b = 0; b < 2; ++b)
#pragma unroll
                for (int m = 0; m < 4; ++m)
#pragma unroll
                    for (int n = 0; n < 2; ++n) acc[a][b][m][n] = (f32x4){0.f, 0.f, 0.f, 0.f};
        cur = nxt; cA = nA; cB = nB; ++ui;
        if constexpr (ALIGN_EPI) { if (wr == 1) PG8_BAR; }
    }
    PG8_WAIT_V(0);
    if constexpr (!ALIGN_EPI) { if (wr == 0) PG8_BAR; }
    PG8_BAR;
    if constexpr (Epi::AFTER_DRAIN) { E.fused(acc, cur, wr, wc, fr, fq, lds, wid, lane); S.done(cur); }
#undef PG8_SA
#undef PG8_SB
#undef PG8_STAGE
#undef PG8_LDA
#undef PG8_LDB
#undef PG8_MMA
#undef PG8_MMAR
#undef PG8_MMA2
#undef PG8_MMA_BODY
#undef PG8_MMAR_BODY
#undef PG8_WAIT_V
#undef PG8_WAIT_L
#undef PG8_BAR
#undef PG8_SCHED
}
}
constexpr int NWAVES = 8;
constexpr int NB = 32, SEQ = 2048, DM = 1024, M = NB * SEQ, NMEM = 256, MM = NB * NMEM;
constexpr int AB_IN = 2304, HG_IN = 4096, DFF = 2816, UPN = 2 * DFF, MH = M / 2;
constexpr float EPS = 1e-6f;
constexpr size_t MiB = 1u << 20;
constexpr size_t WS_CTL = 0, CTL_ZERO_BYTES = 1 * MiB;
constexpr size_t WS_ROWSQ = 2 * MiB;
constexpr size_t WS_LBV = 6 * MiB;
constexpr size_t WS_OSQ = 7 * MiB;
constexpr size_t WS_ROPE = 11 * MiB;
constexpr size_t WS_MEMB = 27 * MiB;
constexpr size_t WS_KV = 43 * MiB;
constexpr size_t WS_W = 75 * MiB;
constexpr size_t WS_XB = 206 * MiB;
constexpr size_t WS_BIG = 334 * MiB;
constexpr size_t WS_HM = 622 * MiB;
constexpr size_t WS_AO = 846 * MiB;
constexpr size_t WS_ACT = WS_BIG;
constexpr size_t WS_EDGE = 686 * MiB;
constexpr size_t WS_END = 974 * MiB;
constexpr size_t W_ABIN = 0, W_ABOUT = 4718592, W_HGIN = 6815744, W_HGOUT = 15204352, W_XQ = 17301504, W_XKV = 21495808, W_XO = 29884416, W_UP = 34078720, W_DOWN = 57147392, W_TOTAL = 68681728;
static_assert(WS_W + W_TOTAL * 2 <= WS_XB && WS_BIG + (size_t)M * HG_IN * 2 <= WS_AO && WS_ACT + (size_t)M * DFF * 2 <= WS_EDGE && WS_EDGE + (size_t)(M / 128) * 4 * UPN * 4 <= WS_AO, "ws map");
static_assert(WS_BIG + (size_t)M * AB_IN * 2 <= WS_HM && WS_HM + (size_t)2 * M * 512 * 2 <= WS_AO, "ws map: head-major K/V");
constexpr int CW_BAR = 4096;
constexpr int RING_BYTES = 131072, LDSCTL_OFF = RING_BYTES, MISC_OFF = LDSCTL_OFF + 320, LDS_BYTES = 147456;

#define GAS __attribute__((address_space(1)))
#define LAS __attribute__((address_space(3)))
typedef unsigned short bf16;
typedef unsigned v4u __attribute__((ext_vector_type(4)));
typedef unsigned v2u __attribute__((ext_vector_type(2)));
typedef float f32x4 __attribute__((ext_vector_type(4)));
typedef float f32x2 __attribute__((ext_vector_type(2)));
typedef GAS unsigned gu32;
#define RLX_AGENT __ATOMIC_RELAXED, __HIP_MEMORY_SCOPE_AGENT
#define LDS_WAIT() asm volatile("s_waitcnt lgkmcnt(0)" ::: "memory")
__device__ __forceinline__ unsigned f2bf(float f) { unsigned u = __builtin_bit_cast(unsigned, f); return (u + 0x7fffu + ((u >> 16) & 1u)) >> 16; }
__device__ __forceinline__ unsigned pk2(float lo, float hi) { return f2bf(lo) | (f2bf(hi) << 16); }
__device__ __forceinline__ float bflo(unsigned w) { return __uint_as_float(w << 16); }
__device__ __forceinline__ float bfhi(unsigned w) { return __uint_as_float(w & 0xffff0000u); }
__device__ __forceinline__ float bf2f(bf16 h) { return __uint_as_float(((unsigned)h) << 16); }
__device__ __forceinline__ void unpack8(const v4u w, float* f) { f[0] = bflo(w.x); f[1] = bfhi(w.x); f[2] = bflo(w.y); f[3] = bfhi(w.y); f[4] = bflo(w.z); f[5] = bfhi(w.z); f[6] = bflo(w.w); f[7] = bfhi(w.w); }
__device__ __forceinline__ v4u pack8(const float* f) { v4u w; w.x = pk2(f[0], f[1]); w.y = pk2(f[2], f[3]); w.z = pk2(f[4], f[5]); w.w = pk2(f[6], f[7]); return w; }
__device__ __forceinline__ float wave_sum(float v) {
#pragma unroll
    for (int o = 1; o < 64; o <<= 1) v += __shfl_xor(v, o);
    return v;
}
__device__ __forceinline__ float wave_max(float v) {
#pragma unroll
    for (int o = 1; o < 64; o <<= 1) v = fmaxf(v, __shfl_xor(v, o));
    return v;
}
#define XB_TMO      128
#define XB_XCNT(j)  (256  + 64 * (j))
#define XB_XSUB(j)  (1280 + 64 * (j))
#define XB_XGEN(j)  (2304 + 64 * (j))
#define XB_TOP      3328
#define XB_TOPGEN   3392
#define XCD_BAR_WORDS 3456
#define XB_SPIN_CAP (1u << 18)

__device__ __forceinline__ unsigned xb_ld(unsigned* p)              { return __hip_atomic_load(p, __ATOMIC_RELAXED, __HIP_MEMORY_SCOPE_AGENT); }
__device__ __forceinline__ unsigned xb_add(unsigned* p, unsigned v) { return __hip_atomic_fetch_add(p, v, __ATOMIC_RELAXED, __HIP_MEMORY_SCOPE_AGENT); }
__device__ __forceinline__ unsigned xb_xcc_id() { return (unsigned)__builtin_amdgcn_s_getreg((3 << 11) | 20) & 0xFu; }
#define XB_SPIN(cond, bar) do { unsigned _sp = 0; while (cond) { __builtin_amdgcn_s_sleep(1); \
    if ((++_sp & 255u) == 0u) { if (xb_ld(&(bar)[XB_TMO])) break; if (_sp > XB_SPIN_CAP) { atomicAdd(&(bar)[XB_TMO], 1u); break; } } } } while (0)

struct XcdBarrier {
    unsigned* bar; unsigned x;
    volatile LAS unsigned* st;
};

__device__ __forceinline__ XcdBarrier xcd_barrier_post(unsigned* bar, volatile LAS unsigned* st) {
    XcdBarrier b; b.bar = bar; b.x = xb_xcc_id(); b.st = st;
    if (threadIdx.x == 0) (void)xb_add(&bar[XB_XCNT(b.x)], 1u);
    return b;
}
__device__ __forceinline__ void xcd_barrier_complete(unsigned* bar, unsigned x, unsigned& nloc, unsigned& nx) {
    const unsigned G = gridDim.x * gridDim.y * gridDim.z;
    unsigned sum, cnt, mine, sp = 0u;
    for (;;) {
        sum = 0u; cnt = 0u; mine = 0u;
#pragma unroll
        for (unsigned j = 0; j < 16; ++j) { const unsigned c = xb_ld(&bar[XB_XCNT(j)]); sum += c; cnt += (c > 0u) ? 1u : 0u; mine = (j == x) ? c : mine; }
        if (sum == G) break;
        __builtin_amdgcn_s_sleep(1);
        if ((++sp & 255u) == 0u) { if (xb_ld(&bar[XB_TMO])) break; if (sp > XB_SPIN_CAP) { atomicAdd(&bar[XB_TMO], 1u); break; } }
    }
    nloc = mine > 0u ? mine : 1u; nx = cnt > 0u ? cnt : 1u;
}

__device__ __attribute__((noinline)) void xcd_barrier(const XcdBarrier b) {
    asm volatile("s_waitcnt vmcnt(0)" ::: "memory");
    __syncthreads();
    if (threadIdx.x == 0) {
        unsigned* bar = b.bar;
        __builtin_amdgcn_s_waitcnt(0);
        unsigned nloc = b.st[0], nx = b.st[1];
        if (nloc == 0u) { xcd_barrier_complete(bar, b.x, nloc, nx); b.st[0] = nloc; b.st[1] = nx; }
        const unsigned old = xb_add(&bar[XB_XSUB(b.x)], 1u);
        const unsigned gen = old / nloc;
        if (old + 1u == (gen + 1u) * nloc) {
            __builtin_amdgcn_fence(__ATOMIC_RELEASE, "agent");
            asm volatile("s_waitcnt vmcnt(0)" ::: "memory");
            const unsigned og = xb_add(&bar[XB_TOP], 1u);
            const unsigned tg = og / nx;
            if (og + 1u == (tg + 1u) * nx) xb_add(&bar[XB_TOPGEN], 1u);
            else XB_SPIN(xb_ld(&bar[XB_TOPGEN]) == tg, bar);
            __builtin_amdgcn_fence(__ATOMIC_ACQUIRE, "agent");
            xb_add(&bar[XB_XGEN(b.x)], 1u);
            asm volatile("s_waitcnt vmcnt(0)" ::: "memory");
        } else {
            XB_SPIN(xb_ld(&bar[XB_XGEN(b.x)]) == gen, bar);
            __builtin_amdgcn_fence(__ATOMIC_ACQUIRE, "agent");
            asm volatile("s_waitcnt vmcnt(0)" ::: "memory");
        }
    }
    __syncthreads();
}
struct Frame {
    LAS unsigned char* lds; volatile LAS unsigned* MISC; gu32* ctl;
    int tid, lane, wave, vcu, G, gw, NGW, gtid, NT;
};
__device__ __forceinline__ Frame fresh(const Frame&) { extern __shared__ __attribute__((aligned(16))) unsigned char lds_[]; Frame F; int t = threadIdx.x; asm volatile("" : "+v"(t)); int bx = blockIdx.x; asm volatile("" : "+s"(bx));
    F.lds = (LAS unsigned char*)lds_; F.MISC = nullptr; F.ctl = nullptr; F.G = gridDim.x; F.vcu = (F.G % 8 == 0) ? (bx % 8) * (F.G / 8) + bx / 8 : bx; F.wave = __builtin_amdgcn_readfirstlane(t >> 6);
    F.NGW = F.G * NWAVES; F.NT = F.G * NWAVES * 64; F.tid = t; F.lane = t & 63; F.gw = F.vcu * NWAVES + F.wave; F.gtid = F.vcu * (NWAVES * 64) + t; return F; }

__device__ __forceinline__ void p0_transpose_item(const float* W, int K, int N, bf16* WT, LAS float* scr, int item, int lane, const float* gain, int mode) {
    const int nblk = N / 32, kb = item / nblk, nb = item % nblk, k0 = 64 * kb, n0 = 32 * nb;
    float wv[32], gv[32];
#pragma unroll
    for (int i = 0; i < 32; ++i) { const int kk = 2 * i + (lane >> 5); wv[i] = W[(size_t)(k0 + kk) * N + n0 + (lane & 31)]; gv[i] = gain ? gain[k0 + kk] : 1.f; }
#pragma unroll
    for (int i = 0; i < 32; ++i) { const int kk = 2 * i + (lane >> 5); scr[kk * 33 + (lane & 31)] = wv[i] * gv[i]; }
    LDS_WAIT(); asm volatile("" ::: "memory");
    int rbase = n0; if (mode == 1) { const int isup = n0 >= DFF ? 1 : 0; const int c = n0 - isup * DFF; rbase = (c / 128) * 256 + isup * 128 + (c % 128); }
    const int c = lane & 7;
#pragma unroll
    for (int j = 0; j < 4; ++j) { const int n = (lane >> 3) + 8 * j; const LAS float* s = scr + (8 * c) * 33 + n;
        v4u o; o.x = pk2(s[0 * 33], s[1 * 33]); o.y = pk2(s[2 * 33], s[3 * 33]); o.z = pk2(s[4 * 33], s[5 * 33]); o.w = pk2(s[6 * 33], s[7 * 33]);
        *(v4u*)(WT + (size_t)(rbase + n) * K + k0 + 8 * c) = o; }
    LDS_WAIT(); asm volatile("" ::: "memory");
}
__device__ __forceinline__ void p0_weights(Frame& F, const float* W, int cnt, int K, int N, bf16* WT, const float* gain, int gain_stride, int mode) {
    LAS float* scr = (LAS float*)(F.lds + F.wave * 16384);
    const int per = (K / 64) * (N / 32);
    for (int it = F.gw; it < cnt * per; it += F.NGW) { const int i = it / per, r = it % per;
        p0_transpose_item(W + (size_t)i * K * N, K, N, WT + (size_t)i * K * N, scr, r, F.lane, gain ? gain + (size_t)i * gain_stride : nullptr, mode); }
}
__device__ __forceinline__ void sincos_rev(double rev, float& s, float& c) {
    const double q = floor(rev * 4.0 + 0.5); const double r = (rev - q * 0.25) * 6.283185307179586476925; const double r2 = r * r;
    const double sn = r * (1.0 + r2 * (-1.0 / 6 + r2 * (1.0 / 120 + r2 * (-1.0 / 5040 + r2 * (1.0 / 362880 + r2 * (-1.0 / 39916800))))));
    const double cs = 1.0 + r2 * (-0.5 + r2 * (1.0 / 24 + r2 * (-1.0 / 720 + r2 * (1.0 / 40320 + r2 * (-1.0 / 3628800 + r2 * (1.0 / 479001600))))));
    const int qi = ((int)q) & 3;
    const double ss = (qi == 0) ? sn : (qi == 1) ? cs : (qi == 2) ? -sn : -cs;
    const double cc = (qi == 0) ? cs : (qi == 1) ? -sn : (qi == 2) ? -cs : sn;
    s = (float)ss; c = (float)cc;
}
typedef const __attribute__((address_space(4))) unsigned char* kaptr_t;
__device__ __forceinline__ const void* in_ptr(int i) { kaptr_t ka = (kaptr_t)__builtin_amdgcn_kernarg_segment_ptr(); asm volatile("" : "+s"(ka)); return *(const void* const __attribute__((address_space(4)))*)(ka + 8 * i); }
#define INF(i) ((const float*)in_ptr(i))
#define OUTP() ((float*)in_ptr(25))
#define WSP() ((unsigned char*)in_ptr(26))
enum { I_X = 0, I_MEM, I_POS, I_NORM_MIX, I_NORM_CROSS, I_NORM_MEM, I_NORM_FFN, I_AB_W_IN, I_AB_W_OUT, I_SWA_Q_NORM, I_SWA_K_NORM, I_SWA_SINKS, I_HGRN_W_IN, I_HGRN_W_OUT, I_HGRN_O_NORM, I_HGRN_LB,
       I_XA_W_Q, I_XA_W_KV, I_XA_W_O, I_XA_Q_NORM, I_XA_K_NORM, I_FFN_W_UP, I_FFN_CONV_W, I_FFN_CONV_B, I_FFN_W_DOWN };
__device__ __forceinline__ void p0_prologue(const Frame& F0) {
    unsigned char* ws = WSP();
    Frame F = fresh(F0);
    bf16* W = (bf16*)(ws + WS_W);
    p0_weights(F, INF(I_AB_W_IN), 2, DM, AB_IN, W + W_ABIN, INF(I_NORM_MIX), 2 * DM, 0);
    p0_weights(F, INF(I_AB_W_OUT), 2, DM, DM, W + W_ABOUT, nullptr, 0, 0);
    p0_weights(F, INF(I_HGRN_W_IN), 2, DM, HG_IN, W + W_HGIN, INF(I_NORM_MIX) + DM, 2 * DM, 0);
    p0_weights(F, INF(I_HGRN_W_OUT), 2, DM, DM, W + W_HGOUT, nullptr, 0, 0);
    p0_weights(F, INF(I_XA_W_Q), 4, DM, DM, W + W_XQ, INF(I_NORM_CROSS), DM, 0);
    p0_weights(F, INF(I_XA_W_KV), 4, DM, 2 * DM, W + W_XKV, INF(I_NORM_MEM), DM, 0);
    p0_weights(F, INF(I_XA_W_O), 4, DM, DM, W + W_XO, nullptr, 0, 0);
    p0_weights(F, INF(I_FFN_W_UP), 4, DM, UPN, W + W_UP, INF(I_NORM_FFN), DM, 1);
    p0_weights(F, INF(I_FFN_W_DOWN), 4, DFF, DM, W + W_DOWN, nullptr, 0, 0);
    bf16* XB = (bf16*)(ws + WS_XB); float* ROWSQ = (float*)(ws + WS_ROWSQ); const float* xin = INF(I_X);
    for (int m0 = F.gw * 4; m0 < M; m0 += F.NGW * 4) {
        f32x4 v[4][4];
#pragma unroll
        for (int r = 0; r < 4; ++r) { const f32x4* xr = (const f32x4*)(xin + (size_t)(m0 + r) * DM) + F.lane;
#pragma unroll
            for (int j = 0; j < 4; ++j) v[r][j] = xr[64 * j]; }
#pragma unroll
        for (int r = 0; r < 4; ++r) { float s = 0.f; v2u* o8 = (v2u*)(XB + (size_t)(m0 + r) * DM) + F.lane;
#pragma unroll
            for (int j = 0; j < 4; ++j) { const f32x4 t = v[r][j]; s += (t.x * t.x + t.y * t.y) + (t.z * t.z + t.w * t.w); v2u w; w.x = pk2(t.x, t.y); w.y = pk2(t.z, t.w); o8[64 * j] = w; }
            s = wave_sum(s); if (F.lane < 16) ROWSQ[(size_t)(m0 + r) * 16 + F.lane] = (F.lane == 0) ? s : 0.f; } }
    bf16* MEMB = (bf16*)(ws + WS_MEMB); const float* memin = INF(I_MEM);
    for (int m = F.gw; m < MM; m += F.NGW) { const f32x4* xr = (const f32x4*)(memin + (size_t)m * DM) + F.lane; float s = 0.f; f32x4 v[4]; v2u* o8 = (v2u*)(MEMB + (size_t)m * DM) + F.lane;
#pragma unroll
        for (int j = 0; j < 4; ++j) { v[j] = xr[64 * j]; s += (v[j].x * v[j].x + v[j].y * v[j].y) + (v[j].z * v[j].z + v[j].w * v[j].w); }
        const float r = 1.0f / sqrtf(wave_sum(s) * (1.0f / DM) + EPS);
#pragma unroll
        for (int j = 0; j < 4; ++j) { v2u w; w.x = pk2(v[j].x * r, v[j].y * r); w.y = pk2(v[j].z * r, v[j].w * r); o8[64 * j] = w; } }
    f32x2* ROPE = (f32x2*)(ws + WS_ROPE); const int* posp = (const int*)in_ptr(I_POS);
    for (int idx = F.gtid; idx < M * 32; idx += F.NT) { const int tok = idx >> 5, i = idx & 31;
        const float inv = (float)exp(-(double)i * (9.210340371976182736 / 32.0)); const float ang = (float)posp[tok] * inv;
        double rev = (double)ang * 0.15915494309189533577; rev -= floor(rev); float s, c; sincos_rev(rev, s, c); ROPE[idx] = (f32x2){c, s}; }
    float* LBV = (float*)(ws + WS_LBV); const float* hlb = INF(I_HGRN_LB);
    for (int c = F.gtid; c < DM; c += F.NT) { const float a0 = hlb[c], a1 = hlb[DM + c], a2 = hlb[2 * DM + c], a3 = hlb[3 * DM + c];
        const float mx = fmaxf(fmaxf(a0, a1), fmaxf(a2, a3)); const float e0 = expf(a0 - mx), e1 = expf(a1 - mx), e2 = expf(a2 - mx), e3 = expf(a3 - mx); const float inv = 1.0f / (((e0 + e1) + e2) + e3);
        const float p0 = e0 * inv, p1 = e1 * inv, p2 = e2 * inv, p3 = e3 * inv;
        LBV[c] = (p0 + p1) - p0; LBV[DM + c] = (((p0 + p1) + p2) + p3) - p0; }
}

__device__ __forceinline__ void swa_kprep(const Frame& F0, bf16* PROJ, const f32x2* ROPE, const float* knorm) {
    Frame F = fresh(F0);
    for (int idx = F.gtid; idx < M * 2; idx += F.NT) { const int tok = idx >> 1, kvh = idx & 1; bf16* kp = PROJ + (size_t)tok * AB_IN + 512 + kvh * 64;
        float f[64]; float ss = 0.f;
#pragma unroll
        for (int i = 0; i < 8; ++i) unpack8(((const v4u*)kp)[i], f + 8 * i);
#pragma unroll
        for (int d = 0; d < 64; ++d) ss += f[d] * f[d];
        const float r = 1.0f / sqrtf(ss * (1.0f / 64) + EPS);
#pragma unroll
        for (int d = 0; d < 64; ++d) f[d] *= r * knorm[d];
        const f32x2* tb = ROPE + (size_t)tok * 32;
#pragma unroll
        for (int i = 0; i < 32; ++i) { const f32x2 cs = tb[i]; const float a = f[i], b = f[i + 32]; f[i] = a * cs.x - b * cs.y; f[i + 32] = b * cs.x + a * cs.y; }
#pragma unroll
        for (int i = 0; i < 8; ++i) ((v4u*)kp)[i] = pack8(f + 8 * i); }
}
__device__ __forceinline__ void swa_naive(const Frame& F0, const bf16* PROJ, bf16* AO, const f32x2* ROPE, const float* qnorm, const float* sinks) {
    Frame F = fresh(F0);
    for (int task = F.gw; task < 8192; task += F.NGW) { const int blk = task & 31, hq = (task >> 5) & 7, b = task >> 8; const int T0 = blk * 64, t = T0 + F.lane, tok = b * SEQ + t;
        float q[64]; float ss = 0.f; const bf16* qp = PROJ + (size_t)tok * AB_IN + hq * 64;
#pragma unroll
        for (int i = 0; i < 8; ++i) unpack8(((const v4u*)qp)[i], q + 8 * i);
#pragma unroll
        for (int d = 0; d < 64; ++d) ss += q[d] * q[d];
        const float r = 0.125f / sqrtf(ss * (1.0f / 64) + EPS);
#pragma unroll
        for (int d = 0; d < 64; ++d) q[d] *= r * qnorm[d];
        const f32x2* tb = ROPE + (size_t)tok * 32;
#pragma unroll
        for (int i = 0; i < 32; ++i) { const f32x2 cs = tb[i]; const float a = q[i], bb = q[i + 32]; q[i] = a * cs.x - bb * cs.y; q[i + 32] = bb * cs.x + a * cs.y; }
        float m = sinks[hq], l = 1.f; float o[64];
#pragma unroll
        for (int d = 0; d < 64; ++d) o[d] = 0.f;
        const int kvh = hq >> 2; const int slo = (T0 - 127) > 0 ? (T0 - 127) : 0;
        for (int s = slo; s <= T0 + 63; ++s) { const bf16* kr = PROJ + (size_t)(b * SEQ + s) * AB_IN + 512 + kvh * 64; float sc = 0.f;
#pragma unroll
            for (int i = 0; i < 8; ++i) { float kf[8]; unpack8(((const v4u*)kr)[i], kf);
#pragma unroll
                for (int j = 0; j < 8; ++j) sc += q[8 * i + j] * kf[j]; }
            const bool valid = (s <= t) && (t - s < 128);
            const float mn = valid ? fmaxf(m, sc) : m; const float alpha = __expf(m - mn); const float p = valid ? __expf(sc - mn) : 0.f; l = l * alpha + p; m = mn;
#pragma unroll
            for (int i = 0; i < 8; ++i) { float vf[8]; unpack8(((const v4u*)(kr + 128))[i], vf);
#pragma unroll
                for (int j = 0; j < 8; ++j) o[8 * i + j] = o[8 * i + j] * alpha + p * vf[j]; } }
        const float inv = 1.0f / l; bf16* op = AO + (size_t)tok * DM + hq * 64;
#pragma unroll
        for (int d = 0; d < 64; ++d) o[d] *= inv;
#pragma unroll
        for (int i = 0; i < 8; ++i) ((v4u*)op)[i] = pack8(o + 8 * i); }
}
__device__ __forceinline__ void sb_naive(const Frame& F0, const bf16* PROJ, bf16* AO) {
    Frame F = fresh(F0);
    for (int task = F.gw; task < 8192; task += F.NGW) { const int rr = task >> 11, g = task & 2047; const int braw = g & 31, bh = rr * 64 + (g >> 5), blk = (rr & 1) ? 31 - braw : braw; const int b = bh >> 3, h = bh & 7;
        const int T0 = blk * 64, t = T0 + F.lane, tok = b * SEQ + t;
        float q[64]; const bf16* qp = PROJ + (size_t)tok * AB_IN + 768 + h * 64;
#pragma unroll
        for (int i = 0; i < 8; ++i) unpack8(((const v4u*)qp)[i], q + 8 * i);
#pragma unroll
        for (int d = 0; d < 64; ++d) q[d] *= 0.125f;
        float la = 0.f; float o[64];
#pragma unroll
        for (int d = 0; d < 64; ++d) o[d] = 0.f;
        for (int s = T0 + 62; s >= 0; --s) { const bf16* kr = PROJ + (size_t)(b * SEQ + s) * AB_IN + 1280 + h * 64; float z = 0.f;
#pragma unroll
            for (int i = 0; i < 8; ++i) { float kf[8]; unpack8(((const v4u*)kr)[i], kf);
#pragma unroll
                for (int j = 0; j < 8; ++j) z += q[8 * i + j] * kf[j]; }
            const bool valid = s < t;
            const float sp = fmaxf(z, 0.f) + log1pf(__expf(-fabsf(z)));
            const float a = valid ? __expf(z - sp + la) : 0.f; la -= valid ? sp : 0.f;
#pragma unroll
            for (int i = 0; i < 8; ++i) { float vf[8]; unpack8(((const v4u*)(kr + 512))[i], vf);
#pragma unroll
                for (int j = 0; j < 8; ++j) o[8 * i + j] += a * vf[j]; } }
        bf16* op = AO + (size_t)tok * DM + 512 + h * 64;
#pragma unroll
        for (int i = 0; i < 8; ++i) ((v4u*)op)[i] = pack8(o + 8 * i); }
}
__device__ __forceinline__ void hgrn_naive(const Frame& F0, const bf16* PROJ, bf16* AO, float* OSQ, const float* lbv) {
    Frame F = fresh(F0);
    if (F.wave < 2) { const int task = F.vcu * 2 + F.wave; if (task < 512) { const int b = task >> 4, h = (task >> 1) & 7, half = task & 1, e = half * 64 + F.lane;
        LAS float* sh = (LAS float*)(F.lds + F.wave * 2048); const LAS f32x4* sh4 = (const LAS f32x4*)sh;
        float S[128];
#pragma unroll
        for (int d = 0; d < 128; ++d) S[d] = 0.f;
        const float lb0 = lbv[h * 128 + F.lane], lb1 = lbv[h * 128 + 64 + F.lane];
        for (int t = 0; t < SEQ; ++t) { const size_t tok = (size_t)b * SEQ + t; const bf16* row = PROJ + tok * HG_IN + h * 128;
            const float q0 = bf2f(row[F.lane]), q1 = bf2f(row[64 + F.lane]), z0 = bf2f(row[1024 + F.lane]), z1 = bf2f(row[1024 + 64 + F.lane]), v = bf2f(row[2048 + e]);
            const float sg0 = 1.0f / (1.0f + __expf(-z0)), sg1 = 1.0f / (1.0f + __expf(-z1));
            sh[F.lane] = q0; sh[64 + F.lane] = q1; sh[128 + F.lane] = lb0 + (1.0f - lb0) * sg0; sh[192 + F.lane] = lb1 + (1.0f - lb1) * sg1;
            sh[256 + F.lane] = (1.0f - lb0) * (1.0f - sg0); sh[320 + F.lane] = (1.0f - lb1) * (1.0f - sg1);
            LDS_WAIT(); asm volatile("" ::: "memory");
            float o = 0.f;
#pragma unroll
            for (int d4 = 0; d4 < 32; ++d4) { const f32x4 qq = sh4[d4], ff = sh4[32 + d4], kk = sh4[64 + d4];
#pragma unroll
                for (int i = 0; i < 4; ++i) { S[4 * d4 + i] = ff[i] * S[4 * d4 + i] + kk[i] * v; o += qq[i] * S[4 * d4 + i]; } }
            LDS_WAIT(); asm volatile("" ::: "memory");
            AO[tok * DM + h * 128 + e] = (bf16)f2bf(o);
            const float ssum = wave_sum(o * o); if (F.lane == 0) OSQ[tok * 16 + h * 2 + half] = ssum; } } }
}
__device__ __forceinline__ void hgrn_post(const Frame& F0, const bf16* PROJ, bf16* AO, const float* OSQ, const float* onorm) {
    Frame F = fresh(F0);
    for (int idx = F.gtid; idx < M * 128; idx += F.NT) { const size_t tok = (size_t)(idx >> 7); const int col = (idx & 127) * 8, h = col >> 7;
        float o[8], g[8]; unpack8(*(const v4u*)(AO + tok * DM + col), o); unpack8(*(const v4u*)(PROJ + tok * HG_IN + 3072 + col), g);
        const float r = 1.0f / sqrtf((OSQ[tok * 16 + h * 2] + OSQ[tok * 16 + h * 2 + 1]) * (1.0f / 128) + EPS);
#pragma unroll
        for (int i = 0; i < 8; ++i) o[i] = o[i] * r * onorm[(col & 127) + i] * (g[i] / (1.0f + __expf(-g[i])));
        *(v4u*)(AO + tok * DM + col) = pack8(o); }
}
__device__ __forceinline__ void cross_naive(const Frame& F0, const bf16* Q, const bf16* KV, bf16* AO, const float* gq, const float* gk) {
    Frame F = fresh(F0);
    LAS float* P = (LAS float*)(F.lds + F.wave * 8192);
    for (int task = F.gw; task < 32768; task += F.NGW) { const int r0 = (task & 255) * 8, hd = (task >> 8) & 3, b = task >> 10;
        const bf16* qb = Q + (size_t)(b * SEQ + r0) * DM + hd * 256; const bf16* kb = KV + (size_t)(b * NMEM) * 2048 + hd * 256;
        float s[8][4], qss[8], kss[4];
#pragma unroll
        for (int r = 0; r < 8; ++r) { qss[r] = 0.f;
#pragma unroll
            for (int j = 0; j < 4; ++j) s[r][j] = 0.f; }
#pragma unroll
        for (int j = 0; j < 4; ++j) kss[j] = 0.f;
#pragma unroll 1
        for (int dc = 0; dc < 32; ++dc) { float G8[8], kf[4][8];
#pragma unroll
            for (int i = 0; i < 8; ++i) G8[i] = gq[dc * 8 + i] * gk[dc * 8 + i];
#pragma unroll
            for (int j = 0; j < 4; ++j) { unpack8(*(const v4u*)(kb + (size_t)(F.lane + 64 * j) * 2048 + dc * 8), kf[j]);
#pragma unroll
                for (int i = 0; i < 8; ++i) kss[j] += kf[j][i] * kf[j][i]; }
#pragma unroll
            for (int r = 0; r < 8; ++r) { float qf[8]; unpack8(*(const v4u*)(qb + (size_t)r * DM + dc * 8), qf);
#pragma unroll
                for (int i = 0; i < 8; ++i) { qss[r] += qf[i] * qf[i]; qf[i] *= G8[i]; }
#pragma unroll
                for (int j = 0; j < 4; ++j)
#pragma unroll
                    for (int i = 0; i < 8; ++i) s[r][j] += qf[i] * kf[j][i]; } }
        float rk[4];
#pragma unroll
        for (int j = 0; j < 4; ++j) rk[j] = 1.0f / sqrtf(kss[j] * (1.0f / 256) + EPS);
#pragma unroll
        for (int r = 0; r < 8; ++r) { const float rq = 0.0625f / sqrtf(qss[r] * (1.0f / 256) + EPS); float mx = -3.0e38f;
#pragma unroll
            for (int j = 0; j < 4; ++j) { s[r][j] *= rq * rk[j]; mx = fmaxf(mx, s[r][j]); }
            mx = wave_max(mx); float sum = 0.f;
#pragma unroll
            for (int j = 0; j < 4; ++j) { s[r][j] = __expf(s[r][j] - mx); sum += s[r][j]; }
            sum = wave_sum(sum); const float inv = 1.0f / sum;
#pragma unroll
            for (int j = 0; j < 4; ++j) P[r * 256 + F.lane + 64 * j] = s[r][j] * inv; }
        LDS_WAIT(); asm volatile("" ::: "memory");
        float o[8][4];
#pragma unroll
        for (int r = 0; r < 8; ++r)
#pragma unroll
            for (int i = 0; i < 4; ++i) o[r][i] = 0.f;
        const bf16* vb = KV + (size_t)(b * NMEM) * 2048 + 1024 + hd * 256 + F.lane * 4;
#pragma unroll 1
        for (int m4 = 0; m4 < 64; ++m4) {
            f32x4 pr[8];
#pragma unroll
            for (int r = 0; r < 8; ++r) pr[r] = *(const LAS f32x4*)(P + r * 256 + m4 * 4);
#pragma unroll
            for (int mm = 0; mm < 4; ++mm) { const v2u vw = *(const v2u*)(vb + (size_t)(m4 * 4 + mm) * 2048); const float v0 = bflo(vw.x), v1 = bfhi(vw.x), v2 = bflo(vw.y), v3 = bfhi(vw.y);
#pragma unroll
                for (int r = 0; r < 8; ++r) { const float p = pr[r][mm]; o[r][0] += p * v0; o[r][1] += p * v1; o[r][2] += p * v2; o[r][3] += p * v3; } } }
        LDS_WAIT(); asm volatile("" ::: "memory");
#pragma unroll
        for (int r = 0; r < 8; ++r) { v2u w; w.x = pk2(o[r][0], o[r][1]); w.y = pk2(o[r][2], o[r][3]); *(v2u*)(AO + (size_t)(b * SEQ + r0 + r) * DM + hd * 256 + F.lane * 4) = w; } }
}
__device__ __forceinline__ void conv_naive(const Frame& F0, const bf16* U, bf16* ACT, const float* cw, const float* cb) {
    Frame F = fresh(F0);
    for (int idx = F.gtid; idx < MH * 22 * 16; idx += F.NT) { const int c8 = idx & 15; const int rj = idx >> 4; const int j = rj % 22, row = rj / 22; const int t = row & (SEQ - 1); const int ch = j * 128 + c8 * 8;
        const bf16* up = U + (size_t)row * UPN + j * 256 + c8 * 8;
        float g0[8], u0[8], g1[8], u1[8], g2[8], u2[8];
        unpack8(*(const v4u*)up, g0); unpack8(*(const v4u*)(up + 128), u0);
        if (t >= 1) { unpack8(*(const v4u*)(up - UPN), g1); unpack8(*(const v4u*)(up - UPN + 128), u1); } else {
#pragma unroll
            for (int i = 0; i < 8; ++i) { g1[i] = 0.f; u1[i] = 0.f; } }
        if (t >= 2) { unpack8(*(const v4u*)(up - 2 * UPN), g2); unpack8(*(const v4u*)(up - 2 * UPN + 128), u2); } else {
#pragma unroll
            for (int i = 0; i < 8; ++i) { g2[i] = 0.f; u2[i] = 0.f; } }
        float o[8];
#pragma unroll
        for (int i = 0; i < 8; ++i) { const int cg = ch + i, cu = DFF + ch + i;
            const float gg = cw[2 * UPN + cg] * g0[i] + cw[UPN + cg] * g1[i] + cw[cg] * g2[i] + cb[cg];
            const float uu = cw[2 * UPN + cu] * u0[i] + cw[UPN + cu] * u1[i] + cw[cu] * u2[i] + cb[cu];
            o[i] = (gg / (1.0f + __expf(-gg))) * uu; }
        *(v4u*)(ACT + (size_t)row * DFF + ch) = pack8(o); }
}
__device__ __forceinline__ void ffn_fix(const Frame& F0, const float* EDGE, bf16* ACT, const float* cw, const float* cb) {
    Frame F = fresh(F0);
    for (int idx = F.gtid; idx < (M / 128) * 352; idx += F.NT) { const int strip = idx / 352, c8 = idx - strip * 352, ch = c8 * 8, colg = 256 * (ch >> 7) + (ch & 127); const bool hp = ((strip * 128) & (SEQ - 1)) != 0;
        const float* e0 = EDGE + (size_t)strip * 4 * UPN; const float* ep = e0 - (hp ? 4 * UPN : 0);
        float o0[8], o1[8];
#pragma unroll
        for (int hlf = 0; hlf < 2; ++hlf) {
            const int col = colg + 128 * hlf, wc0 = hlf * DFF + ch; float r0[8], r1[8], p2[8], p3[8], w0[8], w1[8], w2[8], bb[8];
#pragma unroll
            for (int q = 0; q < 2; ++q) { const f32x4 a = *(const f32x4*)(e0 + col + 4 * q), b = *(const f32x4*)(e0 + UPN + col + 4 * q), c = *(const f32x4*)(ep + 2 * UPN + col + 4 * q), d = *(const f32x4*)(ep + 3 * UPN + col + 4 * q);
                const f32x4 x0 = *(const f32x4*)(cw + wc0 + 4 * q), x1 = *(const f32x4*)(cw + UPN + wc0 + 4 * q), x2 = *(const f32x4*)(cw + 2 * UPN + wc0 + 4 * q), xb = *(const f32x4*)(cb + wc0 + 4 * q);
#pragma unroll
                for (int i = 0; i < 4; ++i) { r0[4 * q + i] = a[i]; r1[4 * q + i] = b[i]; p2[4 * q + i] = hp ? c[i] : 0.f; p3[4 * q + i] = hp ? d[i] : 0.f; w0[4 * q + i] = x0[i]; w1[4 * q + i] = x1[i]; w2[4 * q + i] = x2[i]; bb[4 * q + i] = xb[i]; } }
#pragma unroll
            for (int i = 0; i < 8; ++i) { const float y0 = w2[i] * r0[i] + w1[i] * p3[i] + w0[i] * p2[i] + bb[i], y1 = w2[i] * r1[i] + w1[i] * r0[i] + w0[i] * p3[i] + bb[i];
                if (hlf == 0) { o0[i] = y0 / (1.0f + __expf(-y0)); o1[i] = y1 / (1.0f + __expf(-y1)); } else { o0[i] *= y0; o1[i] *= y1; } } }
        *(v4u*)(ACT + (size_t)(strip * 128) * DFF + ch) = pack8(o0); *(v4u*)(ACT + (size_t)(strip * 128 + 1) * DFF + ch) = pack8(o1); }
}
typedef short bf16x8 __attribute__((ext_vector_type(8)));
typedef unsigned u32x4s __attribute__((ext_vector_type(4)));
typedef short s16x4 __attribute__((ext_vector_type(4)));
typedef short v4i16_t __attribute__((ext_vector_type(4)));
typedef float f32x16 __attribute__((ext_vector_type(16)));
constexpr float LOG2E = 1.4426950408889634f;
__device__ __forceinline__ int img_off(int row, int ch, int c16) { return (row >> 3) * c16 + 512 * (ch >> 2) + 64 * (row & 7) + 16 * ((ch & 3) ^ ((row >> 2) & 3)); }
struct ImgLane { int rd0, rd1, tr0, tr1, wr; };
__device__ __forceinline__ ImgLane img_lane(int lane, int tid) { ImgLane L; const int r32 = lane & 31, h = lane >> 5, blk = (lane >> 4) & 1, q = (lane & 15) >> 2, p = lane & 3;
    L.rd0 = (r32 >> 3) * 1024 + 64 * (r32 & 7) + 16 * (h ^ ((r32 >> 2) & 3)); L.rd1 = L.rd0 ^ 32;
    L.tr0 = 64 * (4 * h + q) + 16 * ((2 * blk + (p >> 1)) ^ h) + 8 * (p & 1); L.tr1 = L.tr0 ^ 32;
    L.wr = img_off(tid >> 3, tid & 7, 1024); return L; }
#define IMG_ROW_READ(img, L, rb, s) (*(const LAS bf16x8*)((img) + (((s) & 1) ? (L).rd1 : (L).rd0) + 4096 * (rb) + 512 * ((s) >> 1)))
__device__ __forceinline__ s16x4 tr_rd(const LAS unsigned char* p) { return __builtin_bit_cast(s16x4, __builtin_amdgcn_ds_read_tr16_b64_v4i16((LAS v4i16_t*)p)); }
#define IMG_TR_FRAG_ACC(dst, img, L, k0, c) do { const s16x4 lo_ = tr_rd((img) + (L).tr0 + ((k0) >> 3) * 1024 + 512 * (c)), hi_ = tr_rd((img) + (L).tr1 + (((k0) >> 3) + 1) * 1024 + 512 * (c)); \
    dst = (bf16x8){lo_[0], lo_[1], lo_[2], lo_[3], hi_[0], hi_[1], hi_[2], hi_[3]}; } while (0)
__device__ __forceinline__ unsigned cvtpk(float lo, float hi) { unsigned r; asm("s_nop 0\n\tv_cvt_pk_bf16_f32 %0, %1, %2" : "=v"(r) : "v"(lo), "v"(hi)); return r; }
__device__ __forceinline__ bf16x8 pack_acc(const f32x16& a, int s) { v4u w; w.x = cvtpk(a[8 * s + 0], a[8 * s + 1]); w.y = cvtpk(a[8 * s + 2], a[8 * s + 3]); w.z = cvtpk(a[8 * s + 4], a[8 * s + 5]); w.w = cvtpk(a[8 * s + 6], a[8 * s + 7]);
    asm volatile("s_nop 1" : "+v"(w));
    return __builtin_bit_cast(bf16x8, w); }
__device__ __forceinline__ float sumsq8(const v4u w) { float f[8]; unpack8(w, f); return ((f[0] * f[0] + f[1] * f[1]) + (f[2] * f[2] + f[3] * f[3])) + ((f[4] * f[4] + f[5] * f[5]) + (f[6] * f[6] + f[7] * f[7])); }
#define MFMA32(a, b, c) __builtin_amdgcn_mfma_f32_32x32x16_bf16((a), (b), (c), 0, 0, 0)
#define WG_BAR() do { asm volatile("s_waitcnt vmcnt(0) lgkmcnt(0)" ::: "memory"); __builtin_amdgcn_s_barrier(); asm volatile("" ::: "memory"); } while (0)
#define WG_BAR_LDS() do { asm volatile("s_waitcnt lgkmcnt(0)" ::: "memory"); __builtin_amdgcn_s_barrier(); asm volatile("" ::: "memory"); } while (0)

__device__ __forceinline__ void cross_mfma(const Frame& F0, const bf16* Q, const bf16* KV, bf16* AO, const float* gq, const float* gk) {
    Frame F = fresh(F0);
    LAS unsigned char* const buf0 = F.lds; LAS unsigned char* const buf1 = F.lds + 65536;
    float M0; { float g = 0.f;
#pragma unroll
        for (int j = 0; j < 4; ++j) g = fmaxf(g, fabsf(gq[F.lane + 64 * j] * gk[F.lane + 64 * j]));
        M0 = __uint_as_float(__builtin_amdgcn_readfirstlane(__float_as_uint(wave_max(g) * (16.0f * LOG2E)))); }
    for (int unit = F.vcu; unit < 1024; unit += F.G) { const int qb = unit & 7, hd = (unit >> 3) & 3, b = unit >> 5;
        int tid2 = threadIdx.x; asm volatile("" : "+v"(tid2));
        const int lane = tid2 & 63, w = F.wave, r32 = lane & 31, h = lane >> 5, prow = tid2 >> 3, pch = tid2 & 7;
        const ImgLane L = img_lane(lane, tid2);
        const int prow2 = prow;
        const bf16* kbase = KV + (size_t)(b * NMEM) * 2048 + hd * 256 + (size_t)prow2 * 2048 + 8 * pch; const bf16* vbase = kbase + 1024;
        const size_t tok = (size_t)b * SEQ + qb * 256 + w * 32 + r32;
        const bf16* qrow = Q + tok * DM + hd * 256 + 8 * h;
        v4u qn[4]; float qss = 0.f, rq = 0.f, l = 0.f;
#pragma unroll
        for (int s = 0; s < 4; ++s) qn[s] = *(const v4u*)(qrow + 16 * s);
        f32x16 acc[4];
#pragma unroll
        for (int kb = 0; kb < 4; ++kb)
#pragma unroll
            for (int i = 0; i < 16; ++i) acc[kb][i] = 0.f;
        bf16x8 pf[8][2];
        v4u pre[8];
#define XK_LOAD(KH_) do { _Pragma("unroll") for (int c = 0; c < 4; ++c) _Pragma("unroll") for (int i = 0; i < 2; ++i) pre[2 * c + i] = *(const v4u*)(kbase + (size_t)(128 * (KH_) + 64 * i) * 2048 + 64 * c); } while (0)
#define XV_LOAD(VH_) do { _Pragma("unroll") for (int j = 0; j < 2; ++j) _Pragma("unroll") for (int i = 0; i < 4; ++i) pre[4 * j + i] = *(const v4u*)(vbase + (size_t)(64 * i) * 2048 + 64 * (2 * (VH_) + j)); } while (0)
        XK_LOAD(0);
        float linv = 0.f;
#pragma unroll
        for (int kh = 0; kh < 2; ++kh) { LAS unsigned char* const buf = kh ? buf1 : buf0;
#pragma unroll
            for (int c = 0; c < 4; ++c)
#pragma unroll
                for (int i = 0; i < 2; ++i) *(LAS v4u*)(buf + 16384 * c + L.wr + 8192 * i) = pre[2 * c + i];
            WG_BAR_LDS();
            if (kh == 0) XK_LOAD(1); else XV_LOAD(0);
#pragma unroll
            for (int dc = 0; dc < 4; ++dc) {
                bf16x8 qf[4];
#pragma unroll
                for (int s = 0; s < 4; ++s) { if (kh == 0) qss += sumsq8(qn[s]); qf[s] = __builtin_bit_cast(bf16x8, qn[s]); }
                if (!(kh == 1 && dc == 3)) {
#pragma unroll
                    for (int s = 0; s < 4; ++s) qn[s] = *(const v4u*)(qrow + 64 * ((dc + 1) & 3) + 16 * s); }
                if (kh == 0 && dc == 3) { qss += __shfl_xor(qss, 32); rq = (0.0625f * LOG2E) / sqrtf(qss * (1.0f / 256) + EPS); }
#pragma unroll
                for (int kb = 0; kb < 4; ++kb) { __builtin_amdgcn_s_setprio(1);
#pragma unroll
                    for (int s = 0; s < 4; ++s) acc[kb] = MFMA32(IMG_ROW_READ(buf + 16384 * dc, L, kb, s), qf[s], acc[kb]);
                    __builtin_amdgcn_s_setprio(0); asm volatile("" ::: "memory"); }
                __builtin_amdgcn_sched_barrier(0); }
#pragma unroll
            for (int kb = 0; kb < 4; ++kb) { asm volatile("" : "+v"(acc[kb]) :: "memory");
#pragma unroll
                for (int i = 0; i < 16; ++i) { const float p = __builtin_amdgcn_exp2f(__builtin_fmaf(acc[kb][i], rq, -M0)); acc[kb][i] = p; l += p; }
                pf[kh * 4 + kb][0] = pack_acc(acc[kb], 0); pf[kh * 4 + kb][1] = pack_acc(acc[kb], 1);
#pragma unroll
                for (int i = 0; i < 16; ++i) acc[kb][i] = 0.f; }
            __builtin_amdgcn_sched_barrier(0);
        }
        l += __shfl_xor(l, 32); linv = 1.0f / l;
#pragma unroll
        for (int vh = 0; vh < 2; ++vh) { LAS unsigned char* const buf = vh ? buf1 : buf0;
#pragma unroll
            for (int j = 0; j < 2; ++j)
#pragma unroll
                for (int i = 0; i < 4; ++i) *(LAS v4u*)(buf + 32768 * j + L.wr + 8192 * i) = pre[4 * j + i];
            WG_BAR_LDS();
            if (vh == 0) XV_LOAD(1);
#pragma unroll
            for (int j = 0; j < 2; ++j) { const int vc = 2 * vh + j;
                f32x16 o[2];
#pragma unroll
                for (int c = 0; c < 2; ++c) {
#pragma unroll
                    for (int i = 0; i < 16; ++i) o[c][i] = 0.f;
#pragma unroll
                    for (int kb = 0; kb < 8; ++kb) { __builtin_amdgcn_s_setprio(1);
#pragma unroll
                        for (int s = 0; s < 2; ++s) { bf16x8 vf; IMG_TR_FRAG_ACC(vf, buf + 32768 * j, L, 32 * kb + 16 * s, c); o[c] = MFMA32(vf, pf[kb][s], o[c]); }
                        __builtin_amdgcn_s_setprio(0); asm volatile("" ::: "memory"); } }
                bf16* op = AO + tok * DM + hd * 256 + 64 * vc + 4 * h;
#pragma unroll
                for (int c = 0; c < 2; ++c)
#pragma unroll
                    for (int g = 0; g < 4; ++g) { v2u wv; wv.x = cvtpk(o[c][4 * g] * linv, o[c][4 * g + 1] * linv); wv.y = cvtpk(o[c][4 * g + 2] * linv, o[c][4 * g + 3] * linv); *(v2u*)(op + 32 * c + 8 * g) = wv; }
                __builtin_amdgcn_sched_barrier(0); }
        }
#undef XK_LOAD
#undef XV_LOAD
    }
    WG_BAR();
}
constexpr float SB_ZSCALE = 0.125f * LOG2E;
template <bool MASKED>
__device__ __forceinline__ void sb_block(const LAS unsigned char* kimg, const LAS unsigned char* vimg, const ImgLane& L, const int kb, const bf16x8 (&qf)[4], f32x16 (&o)[2], float& K, const int key0, const int t, const int h) {
    f32x16 z;
#pragma unroll
    for (int i = 0; i < 16; ++i) z[i] = 0.f;
#pragma unroll
    for (int s = 0; s < 4; ++s) z = MFMA32(IMG_ROW_READ(kimg, L, kb, s), qf[s], z);
    float R[16];
#pragma unroll
    for (int r = 0; r < 16; ++r) { float E = __builtin_amdgcn_exp2f(z[r] * SB_ZSCALE);
        if (MASKED) { const int key = key0 + (r & 3) + 8 * (r >> 2) + 4 * h; E = (key < t) ? E : 0.f; }
        R[r] = __builtin_amdgcn_rcpf(1.0f + E); }
    float G[4], Gp[4], T[4];
#pragma unroll
    for (int g = 0; g < 4; ++g) { G[g] = (R[4 * g] * R[4 * g + 1]) * (R[4 * g + 2] * R[4 * g + 3]); Gp[g] = __shfl_xor(G[g], 32); T[g] = G[g] * Gp[g]; }
    float after[4]; after[3] = K; after[2] = K * T[3]; after[1] = after[2] * T[2]; after[0] = after[1] * T[1];
#pragma unroll
    for (int g = 0; g < 4; ++g) { const float S3 = after[g] * (h == 0 ? Gp[g] : 1.0f), S2 = S3 * R[4 * g + 3], S1 = S2 * R[4 * g + 2], S0 = S1 * R[4 * g + 1], Sm = S0 * R[4 * g];
        z[4 * g + 3] = S3 - S2; z[4 * g + 2] = S2 - S1; z[4 * g + 1] = S1 - S0; z[4 * g + 0] = S0 - Sm; }
    K = after[0] * T[0];
    const bf16x8 p0 = pack_acc(z, 0), p1 = pack_acc(z, 1);
#pragma unroll
    for (int c = 0; c < 2; ++c) { bf16x8 vf; IMG_TR_FRAG_ACC(vf, vimg, L, 32 * kb, c); o[c] = MFMA32(vf, p0, o[c]); IMG_TR_FRAG_ACC(vf, vimg, L, 32 * kb + 16, c); o[c] = MFMA32(vf, p1, o[c]); }
}
__device__ __forceinline__ void sb_tile2(const LAS unsigned char* kimg, const LAS unsigned char* vimg, const ImgLane& L, const bf16x8 (&qf)[4], f32x16 (&o)[2], float& K, const int h) {
    f32x16 z[2];
#pragma unroll
    for (int b = 0; b < 2; ++b)
#pragma unroll
        for (int i = 0; i < 16; ++i) z[b][i] = 0.f;
#pragma unroll
    for (int s = 0; s < 4; ++s) z[1] = MFMA32(IMG_ROW_READ(kimg, L, 1, s), qf[s], z[1]);
#pragma unroll
    for (int s = 3; s >= 0; --s) z[0] = MFMA32(IMG_ROW_READ(kimg, L, 0, s), qf[s], z[0]);
    float R[2][16];
#pragma unroll
    for (int b = 0; b < 2; ++b)
#pragma unroll
        for (int r = 0; r < 16; ++r) { const float E = __builtin_amdgcn_exp2f(z[b][r] * SB_ZSCALE); R[b][r] = __builtin_amdgcn_rcpf(1.0f + E); }
    float G[2][4], Gp[2][4], T[2][4];
#pragma unroll
    for (int b = 0; b < 2; ++b)
#pragma unroll
        for (int g = 0; g < 4; ++g) G[b][g] = (R[b][4 * g] * R[b][4 * g + 1]) * (R[b][4 * g + 2] * R[b][4 * g + 3]);
#pragma unroll
    for (int b = 0; b < 2; ++b)
#pragma unroll
        for (int g = 0; g < 4; ++g) Gp[b][g] = __shfl_xor(G[b][g], 32);
#pragma unroll
    for (int b = 0; b < 2; ++b)
#pragma unroll
        for (int g = 0; g < 4; ++g) T[b][g] = G[b][g] * Gp[b][g];
    const float K1 = K, K0 = K * ((T[1][0] * T[1][1]) * (T[1][2] * T[1][3]));
#pragma unroll
    for (int b = 0; b < 2; ++b) { float after[4]; after[3] = b ? K1 : K0; after[2] = after[3] * T[b][3]; after[1] = after[2] * T[b][2]; after[0] = after[1] * T[b][1];
#pragma unroll
        for (int g = 0; g < 4; ++g) { const float S3 = after[g] * (h == 0 ? Gp[b][g] : 1.0f), S2 = S3 * R[b][4 * g + 3], S1 = S2 * R[b][4 * g + 2], S0 = S1 * R[b][4 * g + 1], Sm = S0 * R[b][4 * g];
            z[b][4 * g + 3] = S3 - S2; z[b][4 * g + 2] = S2 - S1; z[b][4 * g + 1] = S1 - S0; z[b][4 * g + 0] = S0 - Sm; }
        if (b == 0) K = after[0] * T[0][0]; }
    const bf16x8 p10 = pack_acc(z[1], 0), p11 = pack_acc(z[1], 1), p00 = pack_acc(z[0], 0), p01 = pack_acc(z[0], 1);
#pragma unroll
    for (int c = 0; c < 2; ++c) { bf16x8 vf; IMG_TR_FRAG_ACC(vf, vimg, L, 32, c); o[c] = MFMA32(vf, p10, o[c]); IMG_TR_FRAG_ACC(vf, vimg, L, 48, c); o[c] = MFMA32(vf, p11, o[c]);
        IMG_TR_FRAG_ACC(vf, vimg, L, 0, c); o[c] = MFMA32(vf, p00, o[c]); IMG_TR_FRAG_ACC(vf, vimg, L, 16, c); o[c] = MFMA32(vf, p01, o[c]); }
}
#ifndef SB_EXIT_BITS
#define SB_EXIT_BITS 0x00008000u
#endif
__device__ __forceinline__ void sb_mfma(const Frame& F0, const bf16* PROJ, const bf16* HM, bf16* AO) {
    Frame F = fresh(F0);
    const int lane = F.lane, w = F.wave, r32 = lane & 31, h = lane >> 5;
    const ImgLane L = img_lane(lane, F.tid);
    LAS unsigned* const done = (LAS unsigned*)(F.lds + 131072 + 1024);
    if (lane < 2) done[lane * 8 + w] = 0u;
    WG_BAR_LDS();
    unsigned tag = 0u; int fi = 0;
    for (int bh = F.vcu; bh < 256; bh += F.G) { const int b = bh >> 3, hh = bh & 7;
        const bf16* kvb = HM + ((size_t)bh * SEQ + (F.tid >> 3)) * 64 + 8 * (F.tid & 7);
        constexpr size_t VOFF = (size_t)M * 512;
        v4u pk[4], pv[4];
#define SB_LOAD(T_) do { _Pragma("unroll") for (int i = 0; i < 4; ++i) { pk[i] = *(const v4u*)(kvb + (size_t)(256 * (T_) + 64 * i) * 64); pv[i] = *(const v4u*)(kvb + (size_t)(256 * (T_) + 64 * i) * 64 + VOFF); } } while (0)
#define SB_STORE(buf_) do { _Pragma("unroll") for (int i = 0; i < 4; ++i) { *(LAS v4u*)((buf_) + L.wr + 8192 * i) = pk[i]; *(LAS v4u*)((buf_) + 32768 + L.wr + 8192 * i) = pv[i]; } } while (0)
#define SB_WZ() (__all(__float_as_uint(carry) < SB_EXIT_BITS) != 0)
#define SB_ALLDONE(res_) do { const u32x4s d0_ = *(const LAS u32x4s*)(done + (fi & 1) * 8), d1_ = *(const LAS u32x4s*)(done + (fi & 1) * 8 + 4); \
            const unsigned mn_ = min(min(min(d0_.x, d0_.y), min(d0_.z, d0_.w)), min(min(d1_.x, d1_.y), min(d1_.z, d1_.w))); res_ = (unsigned)__builtin_amdgcn_readfirstlane(mn_) >= tag; ++fi; } while (0)
        SB_LOAD(0);
#pragma unroll 1
        for (int qb = 0; qb < 8; ++qb) { const int q0 = 256 * qb + 32 * w, t = q0 + r32; const size_t tok = (size_t)b * SEQ + t;
            bf16x8 qf[4];
#pragma unroll
            for (int s = 0; s < 4; ++s) qf[s] = __builtin_bit_cast(bf16x8, *(const v4u*)(PROJ + tok * AB_IN + 768 + hh * 64 + 16 * s + 8 * h));
            __builtin_amdgcn_s_waitcnt(0x0F70);
            f32x16 o[2];
#pragma unroll
            for (int c = 0; c < 2; ++c)
#pragma unroll
                for (int i = 0; i < 16; ++i) o[c][i] = 0.f;
            float carry = 1.f;
            ++tag; bool wz = false;
            LAS unsigned char* const own = F.lds + (qb & 1) * 65536; LAS unsigned char* const prev = F.lds + ((qb & 1) ^ 1) * 65536;
            SB_STORE(own);
            WG_BAR_LDS();
            if (qb < 7) SB_LOAD(qb + 1);
            { const int hb = w >> 1, j = 4 * qb + hb; const LAS unsigned char* const kimg = own + 8192 * hb; const LAS unsigned char* const vimg = own + 32768 + 8192 * hb;
              if (64 * j + 32 < q0 + 31) sb_block<true>(kimg, vimg, L, 1, qf, o, carry, 64 * j + 32, t, h);
              if (64 * j + 31 < q0) sb_block<false>(kimg, vimg, L, 0, qf, o, carry, 64 * j, t, h); else sb_block<true>(kimg, vimg, L, 0, qf, o, carry, 64 * j, t, h); }
            { const int n = (w >> 1) + (qb > 0 ? 4 : 0);
#pragma unroll 1
              for (int i = 0; i < n; ++i) { if (wz) break; const int hb = (w >> 1) - 1 - i; const LAS unsigned char* const base = (hb >= 0) ? own + 8192 * hb : prev + 8192 * (hb + 4);
                  sb_tile2(base, base + 32768, L, qf, o, carry, h); wz = SB_WZ(); } }
            if (wz && lane == 0) done[(fi & 1) * 8 + w] = tag;
            WG_BAR_LDS();
            if (qb >= 2) { bool alld; SB_ALLDONE(alld);
                if (!alld) {
#pragma unroll 1
                    for (int T = qb - 2; T >= 0; --T) { SB_LOAD(T); SB_STORE(prev); WG_BAR_LDS();
#pragma unroll 1
                        for (int hb = 3; hb >= 0; --hb) { if (wz) break; sb_tile2(prev + 8192 * hb, prev + 32768 + 8192 * hb, L, qf, o, carry, h); wz = SB_WZ(); }
                        if (wz && lane == 0) done[(fi & 1) * 8 + w] = tag;
                        WG_BAR_LDS();
                        SB_ALLDONE(alld); if (alld) break; }
                    if (qb < 7) SB_LOAD(qb + 1); } }
            bf16* op = AO + tok * DM + 512 + hh * 64 + 4 * h;
#pragma unroll
            for (int c = 0; c < 2; ++c)
#pragma unroll
                for (int g = 0; g < 4; ++g) { v2u wv; wv.x = cvtpk(o[c][4 * g], o[c][4 * g + 1]); wv.y = cvtpk(o[c][4 * g + 2], o[c][4 * g + 3]); *(v2u*)(op + 32 * c + 8 * g) = wv; }
        }
#undef SB_LOAD
#undef SB_STORE
#undef SB_WZ
#undef SB_ALLDONE
    }
    WG_BAR();
}
struct ImgLaneW { int rd0, rd1, tr0, tr1, n0, n1, qp; };
__device__ __forceinline__ ImgLaneW img_lane_w(int lane) { ImgLaneW L; const int r32 = lane & 31, h = lane >> 5, blk = (lane >> 4) & 1, q = (lane & 15) >> 2, p = lane & 3, x = (r32 >> 2) & 3;
    L.rd0 = (r32 >> 3) * 2048 + 64 * (r32 & 7) + 16 * (h ^ x); L.rd1 = L.rd0 ^ 32;
    L.tr0 = 64 * (4 * h + q) + 16 * ((2 * blk + (p >> 1)) ^ h) + 8 * (p & 1); L.tr1 = L.tr0 ^ 32;
    L.n0 = h * 2048 + 64 * q + 16 * ((2 * blk + (p >> 1)) ^ (2 * h)) + 8 * (p & 1); L.n1 = (L.n0 ^ 16) + 256;
    L.qp = (r32 >> 3) * 2048 + 64 * (r32 & 7) + 16 * x + 8 * h; return L; }
#define IMGW_ROW_READ(img, L, s) (*(const LAS bf16x8*)((img) + (((s) & 1) ? (L).rd1 : (L).rd0) + 512 * ((s) >> 1)))
#define IMGW_TR_FRAG_ACC(dst, img, L, k0, c) do { const s16x4 lo_ = tr_rd((img) + (L).tr0 + ((k0) >> 3) * 2048 + 512 * (c)), hi_ = tr_rd((img) + (L).tr1 + (((k0) >> 3) + 1) * 2048 + 512 * (c)); \
    dst = (bf16x8){lo_[0], lo_[1], lo_[2], lo_[3], hi_[0], hi_[1], hi_[2], hi_[3]}; } while (0)
#define IMGW_TR_FRAG_NAT(dst, img, L, k0, c) do { const s16x4 lo_ = tr_rd((img) + (L).n0 + ((k0) >> 3) * 2048 + 512 * (c)), hi_ = tr_rd((img) + (L).n1 + ((k0) >> 3) * 2048 + 512 * (c)); \
    dst = (bf16x8){lo_[0], lo_[1], lo_[2], lo_[3], hi_[0], hi_[1], hi_[2], hi_[3]}; } while (0)
#define IMGW_ROW_FRAG_ACC(dst, img, L, db, ks) do { const v2u lo_ = *(const LAS v2u*)((img) + ((L).qp ^ (32 * (ks))) + 512 * (db)), hi_ = *(const LAS v2u*)((img) + ((L).qp ^ (32 * (ks) + 16)) + 512 * (db)); \
    dst = __builtin_bit_cast(bf16x8, (v4u){lo_.x, lo_.y, hi_.x, hi_.y}); } while (0)
__device__ __forceinline__ float scan32(float x) {
    asm volatile("s_nop 4\n\tv_add_f32_dpp %0, %0, %0 row_shr:1 row_mask:0xf bank_mask:0xf bound_ctrl:1" : "+v"(x));
    asm volatile("s_nop 1\n\tv_add_f32_dpp %0, %0, %0 row_shr:2 row_mask:0xf bank_mask:0xf bound_ctrl:1" : "+v"(x));
    asm volatile("s_nop 1\n\tv_add_f32_dpp %0, %0, %0 row_shr:4 row_mask:0xf bank_mask:0xf bound_ctrl:1" : "+v"(x));
    asm volatile("s_nop 1\n\tv_add_f32_dpp %0, %0, %0 row_shr:8 row_mask:0xf bank_mask:0xf bound_ctrl:1" : "+v"(x));
    asm volatile("s_nop 1\n\tv_add_f32_dpp %0, %0, %0 row_bcast:15 row_mask:0xa bank_mask:0xf" : "+v"(x));
    return x; }
__device__ __forceinline__ void scan32x8(float (&x)[8]) {
    asm volatile(
        "s_nop 4\n\t"
        "v_add_f32_dpp %0, %0, %0 row_shr:1 row_mask:0xf bank_mask:0xf bound_ctrl:1\n\tv_add_f32_dpp %1, %1, %1 row_shr:1 row_mask:0xf bank_mask:0xf bound_ctrl:1\n\tv_add_f32_dpp %2, %2, %2 row_shr:1 row_mask:0xf bank_mask:0xf bound_ctrl:1\n\tv_add_f32_dpp %3, %3, %3 row_shr:1 row_mask:0xf bank_mask:0xf bound_ctrl:1\n\tv_add_f32_dpp %4, %4, %4 row_shr:1 row_mask:0xf bank_mask:0xf bound_ctrl:1\n\tv_add_f32_dpp %5, %5, %5 row_shr:1 row_mask:0xf bank_mask:0xf bound_ctrl:1\n\tv_add_f32_dpp %6, %6, %6 row_shr:1 row_mask:0xf bank_mask:0xf bound_ctrl:1\n\tv_add_f32_dpp %7, %7, %7 row_shr:1 row_mask:0xf bank_mask:0xf bound_ctrl:1\n\t"
        "v_add_f32_dpp %0, %0, %0 row_shr:2 row_mask:0xf bank_mask:0xf bound_ctrl:1\n\tv_add_f32_dpp %1, %1, %1 row_shr:2 row_mask:0xf bank_mask:0xf bound_ctrl:1\n\tv_add_f32_dpp %2, %2, %2 row_shr:2 row_mask:0xf bank_mask:0xf bound_ctrl:1\n\tv_add_f32_dpp %3, %3, %3 row_shr:2 row_mask:0xf bank_mask:0xf bound_ctrl:1\n\tv_add_f32_dpp %4, %4, %4 row_shr:2 row_mask:0xf bank_mask:0xf bound_ctrl:1\n\tv_add_f32_dpp %5, %5, %5 row_shr:2 row_mask:0xf bank_mask:0xf bound_ctrl:1\n\tv_add_f32_dpp %6, %6, %6 row_shr:2 row_mask:0xf bank_mask:0xf bound_ctrl:1\n\tv_add_f32_dpp %7, %7, %7 row_shr:2 row_mask:0xf bank_mask:0xf bound_ctrl:1\n\t"
        "v_add_f32_dpp %0, %0, %0 row_shr:4 row_mask:0xf bank_mask:0xf bound_ctrl:1\n\tv_add_f32_dpp %1, %1, %1 row_shr:4 row_mask:0xf bank_mask:0xf bound_ctrl:1\n\tv_add_f32_dpp %2, %2, %2 row_shr:4 row_mask:0xf bank_mask:0xf bound_ctrl:1\n\tv_add_f32_dpp %3, %3, %3 row_shr:4 row_mask:0xf bank_mask:0xf bound_ctrl:1\n\tv_add_f32_dpp %4, %4, %4 row_shr:4 row_mask:0xf bank_mask:0xf bound_ctrl:1\n\tv_add_f32_dpp %5, %5, %5 row_shr:4 row_mask:0xf bank_mask:0xf bound_ctrl:1\n\tv_add_f32_dpp %6, %6, %6 row_shr:4 row_mask:0xf bank_mask:0xf bound_ctrl:1\n\tv_add_f32_dpp %7, %7, %7 row_shr:4 row_mask:0xf bank_mask:0xf bound_ctrl:1\n\t"
        "v_add_f32_dpp %0, %0, %0 row_shr:8 row_mask:0xf bank_mask:0xf bound_ctrl:1\n\tv_add_f32_dpp %1, %1, %1 row_shr:8 row_mask:0xf bank_mask:0xf bound_ctrl:1\n\tv_add_f32_dpp %2, %2, %2 row_shr:8 row_mask:0xf bank_mask:0xf bound_ctrl:1\n\tv_add_f32_dpp %3, %3, %3 row_shr:8 row_mask:0xf bank_mask:0xf bound_ctrl:1\n\tv_add_f32_dpp %4, %4, %4 row_shr:8 row_mask:0xf bank_mask:0xf bound_ctrl:1\n\tv_add_f32_dpp %5, %5, %5 row_shr:8 row_mask:0xf bank_mask:0xf bound_ctrl:1\n\tv_add_f32_dpp %6, %6, %6 row_shr:8 row_mask:0xf bank_mask:0xf bound_ctrl:1\n\tv_add_f32_dpp %7, %7, %7 row_shr:8 row_mask:0xf bank_mask:0xf bound_ctrl:1\n\t"
        "v_add_f32_dpp %0, %0, %0 row_bcast:15 row_mask:0xa bank_mask:0xf\n\tv_add_f32_dpp %1, %1, %1 row_bcast:15 row_mask:0xa bank_mask:0xf\n\tv_add_f32_dpp %2, %2, %2 row_bcast:15 row_mask:0xa bank_mask:0xf\n\tv_add_f32_dpp %3, %3, %3 row_bcast:15 row_mask:0xa bank_mask:0xf\n\tv_add_f32_dpp %4, %4, %4 row_bcast:15 row_mask:0xa bank_mask:0xf\n\tv_add_f32_dpp %5, %5, %5 row_bcast:15 row_mask:0xa bank_mask:0xf\n\tv_add_f32_dpp %6, %6, %6 row_bcast:15 row_mask:0xa bank_mask:0xf\n\tv_add_f32_dpp %7, %7, %7 row_bcast:15 row_mask:0xa bank_mask:0xf\n\t"
        : "+v"(x[0]), "+v"(x[1]), "+v"(x[2]), "+v"(x[3]), "+v"(x[4]), "+v"(x[5]), "+v"(x[6]), "+v"(x[7]));
}
__device__ __forceinline__ float lane_of_half(float x, int l, int h) {
    const float a = __uint_as_float(__builtin_amdgcn_readlane(__float_as_uint(x), l)), b = __uint_as_float(__builtin_amdgcn_readlane(__float_as_uint(x), 32 + l)); return h ? b : a; }
constexpr int HG_QI = 0, HG_KI = 8192, HG_VI = 16384, HG_DEC = 24576, HG_OP = 26624, HG_OPS = 132;
__device__ __forceinline__ void hgrn_mfma(const Frame& F0, const bf16* PROJ, bf16* AO, const float* lbv, const float* onorm) {
    Frame F = fresh(F0);
    const int lane = F.lane, w = F.wave, r32 = lane & 31, h = lane >> 5, es = w & 3, dh = w >> 2;
    const ImgLaneW L = img_lane_w(lane);
    const int pt = lane & 31, dg = 2 * w + (lane >> 5), d0 = dg * 8, et = F.tid >> 4, eg = F.tid & 15;
    LAS unsigned char* const QI = F.lds + HG_QI; LAS unsigned char* const KI = F.lds + HG_KI; LAS unsigned char* const VI = F.lds + HG_VI;
    LAS unsigned char* const QB = F.lds + 61440;
    LAS float* const DEC = (LAS float*)(F.lds + HG_DEC); LAS float* const OP = (LAS float*)(F.lds + HG_OP);
    const int wr = img_off(pt, dg, 2048);
    for (int bh = F.vcu; bh < 256; bh += F.G) { const int b = bh >> 3, hh = bh & 7;
        float lb[8], om[8], on8[8];
#pragma unroll
        for (int i = 0; i < 8; ++i) { lb[i] = lbv[hh * 128 + d0 + i]; om[i] = 1.0f - lb[i]; on8[i] = onorm[eg * 8 + i]; }
        f32x16 S[2];
#pragma unroll
        for (int i = 0; i < 2; ++i)
#pragma unroll
            for (int j = 0; j < 16; ++j) S[i][j] = 0.f;
        const bf16* prow = PROJ + (size_t)(b * SEQ + pt) * HG_IN + hh * 128 + d0;
        const bf16* grow = PROJ + (size_t)(b * SEQ + et) * HG_IN + 3072 + hh * 128 + eg * 8;
        bf16* orow = AO + (size_t)(b * SEQ + et) * DM + hh * 128 + eg * 8;
        v4u nq = *(const v4u*)prow, nz = *(const v4u*)(prow + 1024), nv = *(const v4u*)(prow + 2048), ng = *(const v4u*)grow;
#pragma unroll 1
        for (int c = 0; c < 64; ++c) {
            float q8[8], z8[8], g8[8]; unpack8(nq, q8); unpack8(nz, z8); unpack8(ng, g8); const v4u vraw = nv;
            if (c < 63) { const size_t o = (size_t)(c + 1) * 32 * HG_IN; nq = *(const v4u*)(prow + o); nz = *(const v4u*)(prow + o + 1024); nv = *(const v4u*)(prow + o + 2048); ng = *(const v4u*)(grow + o); }
            float bb[8], k8[8];
#pragma unroll
            for (int i = 0; i < 8; ++i) { const float sg = __builtin_amdgcn_rcpf(1.0f + __builtin_amdgcn_exp2f(-z8[i] * LOG2E)); bb[i] = __builtin_amdgcn_logf(lb[i] + om[i] * sg); k8[i] = om[i] - om[i] * sg; }
            scan32x8(bb);
            float qh[8], kh[8], qb[8];
            float r8[8];
#pragma unroll
            for (int i = 0; i < 8; ++i) r8[i] = __shfl(bb[i], 15 + 32 * h);
#pragma unroll
            for (int i = 0; i < 8; ++i) { const float r = r8[i]; const float fq = __builtin_amdgcn_exp2f(bb[i] - r);
                qh[i] = q8[i] * fq; kh[i] = k8[i] * fminf(__builtin_amdgcn_rcpf(fq), 1.2676506e30f);
                const float eb = __builtin_amdgcn_exp2f(bb[i]);
                qb[i] = q8[i] * eb;
                if (pt == 31) { DEC[128 + d0 + i] = eb; DEC[256 + d0 + i] = fq; } }
            { v4u t; t.x = cvtpk(qh[0], qh[1]); t.y = cvtpk(qh[2], qh[3]); t.z = cvtpk(qh[4], qh[5]); t.w = cvtpk(qh[6], qh[7]); *(LAS v4u*)(QI + wr) = t;
              t.x = cvtpk(qb[0], qb[1]); t.y = cvtpk(qb[2], qb[3]); t.z = cvtpk(qb[4], qb[5]); t.w = cvtpk(qb[6], qb[7]); *(LAS v4u*)(QB + wr) = t;
              t.x = cvtpk(kh[0], kh[1]); t.y = cvtpk(kh[2], kh[3]); t.z = cvtpk(kh[4], kh[5]); t.w = cvtpk(kh[6], kh[7]); *(LAS v4u*)(KI + wr) = t; *(LAS v4u*)(VI + wr) = vraw; }
            WG_BAR_LDS();
            f32x16 X;
#pragma unroll
            for (int j = 0; j < 16; ++j) X[j] = 0.f;
#pragma unroll
            for (int kd = 0; kd < 8; ++kd) X = MFMA32(IMGW_ROW_READ(KI, L, kd), IMGW_ROW_READ(QI, L, kd), X);
#pragma unroll
            for (int j = 0; j < 16; ++j) { const int s = (j & 3) + 8 * (j >> 2) + 4 * h; X[j] = (s <= r32) ? X[j] : 0.f; }
            f32x16 o;
#pragma unroll
            for (int j = 0; j < 16; ++j) o[j] = 0.f;
            { bf16x8 vf; if (dh == 0) { IMGW_TR_FRAG_ACC(vf, VI, L, 0, es); o = MFMA32(pack_acc(X, 0), vf, o); } else { IMGW_TR_FRAG_ACC(vf, VI, L, 16, es); o = MFMA32(pack_acc(X, 1), vf, o); } }
#pragma unroll
            for (int i = 0; i < 2; ++i) { bf16x8 af;
                if (dh == 0) { IMGW_ROW_FRAG_ACC(af, QB, L, i, 0); o = MFMA32(af, pack_acc(S[i], 0), o); IMGW_ROW_FRAG_ACC(af, QB, L, i, 1); o = MFMA32(af, pack_acc(S[i], 1), o); }
                else { IMGW_ROW_FRAG_ACC(af, QB, L, 2 + i, 0); o = MFMA32(af, pack_acc(S[i], 0), o); IMGW_ROW_FRAG_ACC(af, QB, L, 2 + i, 1); o = MFMA32(af, pack_acc(S[i], 1), o); } }
#pragma unroll
            for (int j = 0; j < 16; ++j) { const int t = (j & 3) + 8 * (j >> 2) + 4 * h; OP[(dh * 32 + t) * HG_OPS + 32 * es + r32] = o[j]; }
#pragma unroll
            for (int i = 0; i < 2; ++i) { const int db = 2 * dh + i; f32x16 T;
#pragma unroll
                for (int j = 0; j < 16; ++j) T[j] = 0.f;
                bf16x8 af, bf;
                if (dh == 0) { IMGW_TR_FRAG_NAT(af, KI, L, 0, i); IMGW_TR_FRAG_NAT(bf, VI, L, 0, es); T = MFMA32(af, bf, T); IMGW_TR_FRAG_NAT(af, KI, L, 16, i); IMGW_TR_FRAG_NAT(bf, VI, L, 16, es); T = MFMA32(af, bf, T); }
                else { IMGW_TR_FRAG_NAT(af, KI, L, 0, 2 + i); IMGW_TR_FRAG_NAT(bf, VI, L, 0, es); T = MFMA32(af, bf, T); IMGW_TR_FRAG_NAT(af, KI, L, 16, 2 + i); IMGW_TR_FRAG_NAT(bf, VI, L, 16, es); T = MFMA32(af, bf, T); }
#pragma unroll
                for (int g = 0; g < 4; ++g) { const f32x4 d1 = *(const LAS f32x4*)(DEC + 128 + 32 * db + 8 * g + 4 * h), d2 = *(const LAS f32x4*)(DEC + 256 + 32 * db + 8 * g + 4 * h);
#pragma unroll
                    for (int j = 0; j < 4; ++j) { const float s1 = S[i][4 * g + j] * d1[j]; S[i][4 * g + j] = __builtin_fmaf(T[4 * g + j], d2[j], s1); } } }
            WG_BAR_LDS();
            { const f32x4 a0 = *(const LAS f32x4*)(OP + et * HG_OPS + 8 * eg), a1 = *(const LAS f32x4*)(OP + et * HG_OPS + 8 * eg + 4), b0 = *(const LAS f32x4*)(OP + (32 + et) * HG_OPS + 8 * eg), b1 = *(const LAS f32x4*)(OP + (32 + et) * HG_OPS + 8 * eg + 4);
              float ov[8] = {a0[0] + b0[0], a0[1] + b0[1], a0[2] + b0[2], a0[3] + b0[3], a1[0] + b1[0], a1[1] + b1[1], a1[2] + b1[2], a1[3] + b1[3]};
              float ss = ((ov[0] * ov[0] + ov[1] * ov[1]) + (ov[2] * ov[2] + ov[3] * ov[3])) + ((ov[4] * ov[4] + ov[5] * ov[5]) + (ov[6] * ov[6] + ov[7] * ov[7]));
              ss += __shfl_xor(ss, 1); ss += __shfl_xor(ss, 2); ss += __shfl_xor(ss, 4); ss += __shfl_xor(ss, 8);
              const float rr = __builtin_amdgcn_rsqf(ss * (1.0f / 128) + EPS);
#pragma unroll
              for (int i = 0; i < 8; ++i) ov[i] = ov[i] * rr * on8[i] * (g8[i] * __builtin_amdgcn_rcpf(1.0f + __builtin_amdgcn_exp2f(-g8[i] * LOG2E)));
              v4u t; t.x = cvtpk(ov[0], ov[1]); t.y = cvtpk(ov[2], ov[3]); t.z = cvtpk(ov[4], ov[5]); t.w = cvtpk(ov[6], ov[7]);
              *(v4u*)(orow + (size_t)c * 32 * DM) = t; }
        }
    }
    WG_BAR();
}
__device__ __forceinline__ void swa_mfma(const Frame& F0, const bf16* PROJ, bf16* AO, const f32x2* ROPE, const float* qnorm, const float* knorm, const float* sinks) {
    Frame F = fresh(F0);
    const int lane = F.lane, w = F.wave, r32 = lane & 31, h = lane >> 5, g = w >> 1;
    const ImgLane L = img_lane(lane, F.tid);
    LAS unsigned char* const KI = F.lds; LAS unsigned char* const VI = F.lds + 32768;
    for (int unit = F.vcu; unit < 1024; unit += F.G) { const int qb = unit & 15, kvh = (unit >> 4) & 1, b = unit >> 5; const int key00 = 128 * (qb - 1);
#pragma unroll
        for (int i = 0; i < 2; ++i) { const int id = F.tid + 512 * i, kr = id >> 2, c = id & 3, key = key00 + kr; const bool kv = key >= 0; const size_t tokk = (size_t)b * SEQ + (kv ? key : 0);
            const bf16* p = PROJ + tokk * AB_IN + 512 + kvh * 64 + 8 * c; v4u a = *(const v4u*)p, bq = *(const v4u*)(p + 32);
            float x1[8], x2[8]; unpack8(a, x1); unpack8(bq, x2); float ss = 0.f;
#pragma unroll
            for (int j = 0; j < 8; ++j) ss += x1[j] * x1[j] + x2[j] * x2[j];
            ss += __shfl_xor(ss, 1); ss += __shfl_xor(ss, 2);
            const float r = kv ? 1.0f / sqrtf(ss * (1.0f / 64) + EPS) : 0.f; const f32x2* tb = ROPE + tokk * 32 + 8 * c;
#pragma unroll
            for (int j = 0; j < 8; ++j) { const f32x2 cs = tb[j]; const float y1 = x1[j] * r * knorm[8 * c + j], y2 = x2[j] * r * knorm[32 + 8 * c + j]; x1[j] = y1 * cs.x - y2 * cs.y; x2[j] = y2 * cs.x + y1 * cs.y; }
            a.x = cvtpk(x1[0], x1[1]); a.y = cvtpk(x1[2], x1[3]); a.z = cvtpk(x1[4], x1[5]); a.w = cvtpk(x1[6], x1[7]); bq.x = cvtpk(x2[0], x2[1]); bq.y = cvtpk(x2[2], x2[3]); bq.z = cvtpk(x2[4], x2[5]); bq.w = cvtpk(x2[6], x2[7]);
            *(LAS v4u*)(KI + img_off(kr, c, 1024)) = a; *(LAS v4u*)(KI + img_off(kr, c + 4, 1024)) = bq; }
#pragma unroll
        for (int i = 0; i < 4; ++i) { const int key = key00 + (F.tid >> 3) + 64 * i; v4u v = (v4u){0u, 0u, 0u, 0u};
            if (key >= 0) v = *(const v4u*)(PROJ + ((size_t)b * SEQ + key) * AB_IN + 640 + kvh * 64 + 8 * (F.tid & 7));
            *(LAS v4u*)(VI + L.wr + 8192 * i) = v; }
        WG_BAR_LDS();
        const int hq = kvh * 4 + g; const float sink2 = sinks[hq] * LOG2E;
#pragma unroll 1
        for (int sbi = 0; sbi < 2; ++sbi) { const int sb = (w & 1) * 2 + sbi, t = 128 * qb + 32 * sb + r32; const size_t tok = (size_t)b * SEQ + t;
            bf16x8 qf[4];
            { const bf16* qp = PROJ + tok * AB_IN + hq * 64 + 8 * h; float x[4][8]; float ss = 0.f;
#pragma unroll
              for (int s = 0; s < 4; ++s) { unpack8(*(const v4u*)(qp + 16 * s), x[s]);
#pragma unroll
                  for (int j = 0; j < 8; ++j) ss += x[s][j] * x[s][j]; }
              ss += __shfl_xor(ss, 32); const float r = (0.125f * LOG2E) / sqrtf(ss * (1.0f / 64) + EPS); const f32x2* tb = ROPE + tok * 32 + 8 * h;
#pragma unroll
              for (int s = 0; s < 2; ++s)
#pragma unroll
                  for (int j = 0; j < 8; ++j) { const f32x2 cs = tb[16 * s + j]; const float y1 = x[s][j] * r * qnorm[16 * s + 8 * h + j], y2 = x[s + 2][j] * r * qnorm[32 + 16 * s + 8 * h + j];
                      x[s][j] = y1 * cs.x - y2 * cs.y; x[s + 2][j] = y2 * cs.x + y1 * cs.y; }
#pragma unroll
              for (int s = 0; s < 4; ++s) { v4u t4; t4.x = cvtpk(x[s][0], x[s][1]); t4.y = cvtpk(x[s][2], x[s][3]); t4.z = cvtpk(x[s][4], x[s][5]); t4.w = cvtpk(x[s][6], x[s][7]); asm volatile("s_nop 1" : "+v"(t4)); qf[s] = __builtin_bit_cast(bf16x8, t4); } }
            f32x16 acc[5]; float mx = sink2;
            const LAS unsigned char* kimg = KI + 4096 * sb; const LAS unsigned char* vimg = VI + 4096 * sb;
#pragma unroll
            for (int j = 0; j < 5; ++j) {
#pragma unroll
                for (int i = 0; i < 16; ++i) acc[j][i] = 0.f;
#pragma unroll
                for (int s = 0; s < 4; ++s) acc[j] = MFMA32(IMG_ROW_READ(kimg, L, j, s), qf[s], acc[j]);
                int rr = r32; asm volatile("" : "+v"(rr)); const bool blk_ok = (key00 + 32 * (sb + j)) >= 0;
#pragma unroll
                for (int i = 0; i < 16; ++i) { const int kap = (i & 3) + 8 * (i >> 2) + 4 * h; const bool valid = blk_ok && (j == 0 ? kap > rr : (j == 4 ? kap <= rr : true));
                    const float v = valid ? acc[j][i] : -3.0e38f; acc[j][i] = v; mx = fmaxf(mx, v); } }
            mx = fmaxf(mx, __shfl_xor(mx, 32)); float l = 0.f;
#pragma unroll
            for (int j = 0; j < 5; ++j)
#pragma unroll
                for (int i = 0; i < 16; ++i) { const float p = __builtin_amdgcn_exp2f(acc[j][i] - mx); acc[j][i] = p; l += p; }
            l += __shfl_xor(l, 32); l += __builtin_amdgcn_exp2f(sink2 - mx); const float linv = 1.0f / l;
            f32x16 o[2];
#pragma unroll
            for (int c = 0; c < 2; ++c) {
#pragma unroll
                for (int i = 0; i < 16; ++i) o[c][i] = 0.f;
#pragma unroll
                for (int j = 0; j < 5; ++j)
#pragma unroll
                    for (int ks = 0; ks < 2; ++ks) { bf16x8 vf; IMG_TR_FRAG_ACC(vf, vimg, L, 32 * j + 16 * ks, c); o[c] = MFMA32(vf, pack_acc(acc[j], ks), o[c]); } }
            bf16* op = AO + tok * DM + hq * 64 + 4 * h;
#pragma unroll
            for (int c = 0; c < 2; ++c)
#pragma unroll
                for (int gg = 0; gg < 4; ++gg) { v2u wv; wv.x = cvtpk(o[c][4 * gg] * linv, o[c][4 * gg + 1] * linv); wv.y = cvtpk(o[c][4 * gg + 2] * linv, o[c][4 * gg + 3] * linv); *(v2u*)(op + 32 * c + 8 * gg) = wv; }
        }
        WG_BAR_LDS();
    }
    WG_BAR();
}
struct Args { const void* in[25]; float* out; unsigned char* ws; };
#if defined(__HIP_DEVICE_COMPILE__)
#define NO_PK_F32 __attribute__((target("no-packed-fp32-ops")))
#else
#define NO_PK_F32
#endif
__global__ void __launch_bounds__(NWAVES * 64, 2) NO_PK_F32 trunk_fwd(Args args) {
    extern __shared__ __attribute__((aligned(16))) unsigned char lds[];
    Frame F;
    F.lds = (LAS unsigned char*)lds; F.MISC = (volatile LAS unsigned*)(F.lds + MISC_OFF);
    F.tid = 0; F.lane = 0; F.gtid = 0; F.gw = 0; F.wave = __builtin_amdgcn_readfirstlane(threadIdx.x >> 6);
    F.G = gridDim.x; { const int bx = blockIdx.x; F.vcu = (F.G % 8 == 0) ? (bx % 8) * (F.G / 8) + bx / 8 : bx; }
    F.NGW = F.G * NWAVES; F.NT = F.G * NWAVES * 64;
    F.ctl = (gu32*)(args.ws + WS_CTL);
    for (int u = threadIdx.x; u < (LDS_BYTES - LDSCTL_OFF) / 4; u += NWAVES * 64) ((LAS unsigned*)(F.lds + LDSCTL_OFF))[u] = 0u;
    asm volatile("s_waitcnt lgkmcnt(0)\n\ts_barrier" ::: "memory");
    XcdBarrier bar = xcd_barrier_post((unsigned*)(F.ctl + CW_BAR), F.MISC + 8);
#define GRID_BAR() xcd_barrier(bar)
    typedef pg8::EpiScaleBf16 ES; typedef pg8::EpiRes ER; typedef pg8::EpiConvGlu EC;
#ifndef REP_G
#define REP_G 1
#endif
#ifndef REP_M
#define REP_M 1
#endif
#ifndef REP_X
#define REP_X 1
#endif
#ifndef REP_H
#define REP_H 1
#endif
#ifndef REP_W
#define REP_W 1
#endif
#ifndef REP_R
#define REP_R 1
#endif
#ifndef REP_SB
#define REP_SB 1
#endif
#ifndef REP_P
#define REP_P 1
#endif
#ifndef REP_C
#define REP_C 1
#endif
#define REPLOOP(n) _Pragma("unroll 1") for (int rep_ = 0; rep_ < (n); ++rep_)
#define RS_LDS ((LAS float*)(F.lds + RING_BYTES + 1024))
#define opq_bx() ({ int bx_ = blockIdx.x; asm volatile("" : "+s"(bx_)); bx_; })
#define opq_g() ({ int g_ = gridDim.x; asm volatile("" : "+s"(g_)); g_; })

#ifndef NO_PRO
    REPLOOP(REP_P) p0_prologue(F);
#endif
    GRID_BAR();
#define WS_BF(off) ((bf16*)(WSP() + (off)))
#define WS_F32(off) ((float*)(WSP() + (off)))
#pragma unroll 1
    for (int l = 0; l < 4; ++l) {
        const int par = l & 1, e = l >> 1;
        { const int N1 = par ? HG_IN : AB_IN; const bf16* Wt = WS_BF(WS_W) + (par ? W_HGIN + (size_t)e * DM * HG_IN : W_ABIN + (size_t)e * DM * AB_IN);
          pg8::Gemm g{WS_BF(WS_XB), Wt, M, N1, DM}; pg8::StaticOrder S; S.init(M, N1, opq_g(), opq_bx()); ES E{WS_BF(WS_BIG), N1, WS_F32(WS_ROWSQ), RS_LDS, par ? nullptr : WS_BF(WS_HM), 5, (size_t)M * 512};
          REPLOOP(REP_G) pg8::gemm_phase<ES, pg8::StaticOrder, true, true>(F.lds, g, S, E); }
        GRID_BAR();
        if (!par) {
#ifdef NAIVE_SWA
            swa_kprep(F, WS_BF(WS_BIG), (const f32x2*)WS_F32(WS_ROPE), INF(I_SWA_K_NORM) + e * 64);
            GRID_BAR();
            swa_naive(F, WS_BF(WS_BIG), WS_BF(WS_AO), (const f32x2*)WS_F32(WS_ROPE), INF(I_SWA_Q_NORM) + e * 64, INF(I_SWA_SINKS) + e * 8);
#else
            REPLOOP(REP_W) swa_mfma(F, WS_BF(WS_BIG), WS_BF(WS_AO), (const f32x2*)WS_F32(WS_ROPE), INF(I_SWA_Q_NORM) + e * 64, INF(I_SWA_K_NORM) + e * 64, INF(I_SWA_SINKS) + e * 8);
#endif
#ifdef NAIVE_SB
            sb_naive(F, WS_BF(WS_BIG), WS_BF(WS_AO));
#else
            REPLOOP(REP_SB) sb_mfma(F, WS_BF(WS_BIG), WS_BF(WS_HM), WS_BF(WS_AO));
#endif
        } else {
#ifdef NAIVE_HGRN
            hgrn_naive(F, WS_BF(WS_BIG), WS_BF(WS_AO), WS_F32(WS_OSQ), WS_F32(WS_LBV) + e * DM);
            GRID_BAR();
            hgrn_post(F, WS_BF(WS_BIG), WS_BF(WS_AO), WS_F32(WS_OSQ), INF(I_HGRN_O_NORM) + e * 128);
#else
            REPLOOP(REP_H) hgrn_mfma(F, WS_BF(WS_BIG), WS_BF(WS_AO), WS_F32(WS_LBV) + e * DM, INF(I_HGRN_O_NORM) + e * 128);
#endif
        }
        GRID_BAR();
        { const bf16* Wt = WS_BF(WS_W) + (par ? W_HGOUT : W_ABOUT) + (size_t)e * DM * DM;
          pg8::Gemm g{WS_BF(WS_AO), Wt, M, DM, DM}; pg8::StaticOrder S; S.init(M, DM, opq_g(), opq_bx()); ER E{nullptr, WS_BF(WS_XB), WS_F32(WS_ROWSQ), false, WS_BF(WS_XB)};
#if REP_R > 1
          { ER Ed{nullptr, WS_BF(WS_XB), WS_F32(WS_OSQ), false, WS_BF(WS_BIG)}; pg8::gemm_phase<ER, pg8::StaticOrder, true, true>(F.lds, g, S, Ed); }
#endif
          pg8::gemm_phase<ER, pg8::StaticOrder, true, true>(F.lds, g, S, E); }
        GRID_BAR();
        { pg8::Gemm g{WS_BF(WS_XB), WS_BF(WS_W) + W_XQ + (size_t)l * DM * DM, M, DM, DM}; pg8::StaticOrder S; S.init(M, DM, opq_g(), opq_bx()); ES E{WS_BF(WS_BIG), DM, WS_F32(WS_ROWSQ), RS_LDS, nullptr, 0, 0};
          REPLOOP(REP_G) pg8::gemm_phase<ES, pg8::StaticOrder, true, true>(F.lds, g, S, E); }
        { pg8::Gemm g{WS_BF(WS_MEMB), WS_BF(WS_W) + W_XKV + (size_t)l * DM * 2 * DM, MM, 2 * DM, DM}; pg8::StaticOrder S; S.init(MM, 2 * DM, opq_g(), opq_bx()); pg8::EpiKV E{WS_BF(WS_KV), 2 * DM, INF(I_XA_Q_NORM) + l * 256, INF(I_XA_K_NORM) + l * 256, RS_LDS};
          REPLOOP(REP_G) pg8::gemm_phase<pg8::EpiKV, pg8::StaticOrder, true, true>(F.lds, g, S, E); }
        GRID_BAR();
#ifdef NAIVE_CROSS
        cross_naive(F, WS_BF(WS_BIG), WS_BF(WS_KV), WS_BF(WS_AO), INF(I_XA_Q_NORM) + l * 256, INF(I_XA_K_NORM) + l * 256);
#else
        REPLOOP(REP_X) cross_mfma(F, WS_BF(WS_BIG), WS_BF(WS_KV), WS_BF(WS_AO), INF(I_XA_Q_NORM) + l * 256, INF(I_XA_K_NORM) + l * 256);
#endif
        GRID_BAR();
        { pg8::Gemm g{WS_BF(WS_AO), WS_BF(WS_W) + W_XO + (size_t)l * DM * DM, M, DM, DM}; pg8::StaticOrder S; S.init(M, DM, opq_g(), opq_bx()); ER E{nullptr, WS_BF(WS_XB), WS_F32(WS_ROWSQ), false, WS_BF(WS_XB)};
#if REP_R > 1
          { ER Ed{nullptr, WS_BF(WS_XB), WS_F32(WS_OSQ), false, WS_BF(WS_BIG)}; pg8::gemm_phase<ER, pg8::StaticOrder, true, true>(F.lds, g, S, Ed); }
#endif
          pg8::gemm_phase<ER, pg8::StaticOrder, true, true>(F.lds, g, S, E); }
        GRID_BAR();
        { pg8::Gemm g{WS_BF(WS_XB), WS_BF(WS_W) + W_UP + (size_t)l * DM * UPN, M, UPN, DM}; pg8::StaticOrder S; S.init(M, UPN, opq_g(), opq_bx());
          EC E{WS_BF(WS_ACT), WS_F32(WS_ROWSQ), INF(I_FFN_CONV_W) + (size_t)l * 3 * UPN, INF(I_FFN_CONV_B) + (size_t)l * UPN, WS_F32(WS_EDGE), RS_LDS};
          REPLOOP(REP_G) pg8::gemm_phase<EC, pg8::StaticOrder, true, true, true>(F.lds, g, S, E); }
        GRID_BAR();
        ffn_fix(F, WS_F32(WS_EDGE), WS_BF(WS_ACT), INF(I_FFN_CONV_W) + (size_t)l * 3 * UPN, INF(I_FFN_CONV_B) + (size_t)l * UPN);
        GRID_BAR();
        { pg8::Gemm g{WS_BF(WS_ACT), WS_BF(WS_W) + W_DOWN + (size_t)l * DFF * DM, M, DM, DFF}; pg8::StaticOrder S; S.init(M, DM, opq_g(), opq_bx()); ER E{OUTP(), WS_BF(WS_XB), WS_F32(WS_ROWSQ), l == 3, WS_BF(WS_XB)};
#if REP_R > 1
          { ER Ed{nullptr, WS_BF(WS_XB), WS_F32(WS_OSQ), false, WS_BF(WS_AO)}; pg8::gemm_phase<ER, pg8::StaticOrder, true, true>(F.lds, g, S, Ed); }
#endif
          pg8::gemm_phase<ER, pg8::StaticOrder, true, true>(F.lds, g, S, E); }
        GRID_BAR();
    }
}

extern "C" void kernel_launch(void* const* d_in, const int* in_sizes, int n_in, void* d_out, int out_size, void* d_ws, size_t ws_size, hipStream_t stream) {
    static int grid = 0;
    if (grid == 0) {
        if (n_in != 25 || in_sizes[0] != M * DM || out_size != M * DM || ws_size < WS_END) { fprintf(stderr, "kernel_launch: unexpected shapes / workspace (n_in %d, in0 %d, out %d, ws %zu < %zu); nothing launched\n", n_in, n_in > 0 ? in_sizes[0] : -1, out_size, ws_size, (size_t)WS_END); grid = -1; return; }
        int dev = 0, cus = 0, per_cu = 0;
        if (hipGetDevice(&dev) != hipSuccess || hipDeviceGetAttribute(&cus, hipDeviceAttributeMultiprocessorCount, dev) != hipSuccess) { grid = -1; return; }
        if (hipFuncSetAttribute((const void*)trunk_fwd, hipFuncAttributeMaxDynamicSharedMemorySize, LDS_BYTES) != hipSuccess) { fprintf(stderr, "kernel_launch: hipFuncSetAttribute failed\n"); grid = -1; return; }
        if (hipOccupancyMaxActiveBlocksPerMultiprocessor(&per_cu, (const void*)trunk_fwd, NWAVES * 64, LDS_BYTES) != hipSuccess || per_cu < 1) fprintf(stderr, "kernel_launch: note: occupancy query reports %d\n", per_cu);
        (void)hipGetLastError();
        grid = cus;
    }
    if (grid < 0) return;
    if (hipMemsetAsync((char*)d_ws + WS_CTL, 0, CTL_ZERO_BYTES, stream) != hipSuccess) return;
    Args a{};
    for (int i = 0; i < 25; ++i) a.in[i] = d_in[i];
    a.out = (float*)d_out; a.ws = (unsigned char*)d_ws;
    hipLaunchKernelGGL(trunk_fwd, dim3(grid), dim3(NWAVES * 64), LDS_BYTES, stream, a);
}
```

```cpp
#include <hip/hip_runtime.h>
#include <cstdio>
#include <cstdint>
#include <cmath>
namespace pg8 {
#define PG8_LAS __attribute__((address_space(3)))
typedef unsigned short bf16_t;
typedef short bf16x8 __attribute__((ext_vector_type(8)));
typedef float f32x4 __attribute__((ext_vector_type(4)));
typedef unsigned u32x4 __attribute__((ext_vector_type(4)));
constexpr int BM = 256, BK = 64, HALF = 128, HTB = HALF * BK * 2  , STAGE_BYTES = 8 * HTB, NXCD = 8, WGM = 8;

__host__ __device__ __forceinline__ int lds_byte(int r, int c) { const int st = (r >> 4) * 2 + (c >> 5), rr = r & 15, cc = c & 31, ob = rr * 64 + cc * 2; return st * 1024 + (ob ^ (((ob >> 9) & 1) << 5)); }
__host__ __device__ __forceinline__ void stage_rc(int b, int& R, int& C) { const int st = b / 1024, sb = b % 1024, swz = sb ^ (((sb >> 9) & 1) << 5); R = (st >> 1) * 16 + swz / 64; C = (st & 1) * 32 + (swz % 64) / 2; }
__host__ __device__ __forceinline__ int perm32(int rho) { const int n = rho >> 4, i = rho & 15; return 8 * (i >> 2) + 4 * n + (i & 3); }

struct Unit { int pm, pn; };
struct Gemm { const bf16_t* A; const bf16_t* Bt; int M, N, K; };

struct StaticOrder {
    int nM, nN, nwg, G, c;
    __host__ __device__ __forceinline__ void init(int M, int N, int G_, int c_) { nM = M / BM; nN = N / BM; nwg = nM * nN; G = G_; c = c_; }
    __host__ __device__ __forceinline__ bool next(int i, Unit& u) const {
        const long L = (long)i * G + c; if (L >= nwg) return false;
        int wgid = (int)L; { const int q = nwg / NXCD, r = nwg % NXCD, xcd = wgid % NXCD, off = wgid / NXCD; wgid = (xcd < r ? xcd * (q + 1) : r * (q + 1) + (xcd - r) * q) + off; }
        const int nig = WGM * nN, gid = wgid / nig, fm = gid * WGM, gsz = (nM - fm) < WGM ? (nM - fm) : WGM;
        u.pm = fm + ((wgid % nig) % gsz); u.pn = (wgid % nig) / gsz; return true;
    }
    __device__ __forceinline__ void a_ready(const Unit&) const {}
    __device__ __forceinline__ void done(const Unit&) const {}
};

__device__ __forceinline__ unsigned cvt_pk_bf16(float lo, float hi) { unsigned r; asm volatile("v_cvt_pk_bf16_f32 %0, %1, %2" : "=v"(r) : "v"(lo), "v"(hi)); return r; }
typedef float f32x2 __attribute__((ext_vector_type(2)));

__device__ __forceinline__ void unit_rstd(PG8_LAS float* rs, const float* rowsq, int pm) {
    int t = threadIdx.x; asm volatile("" : "+v"(t));
    if (t < 256) { const f32x4* rp = (const f32x4*)(rowsq + (size_t)(pm * BM + t) * 16); const f32x4 a = rp[0], b = rp[1], c = rp[2], d = rp[3];
        const float s = ((a[0] + a[1]) + (a[2] + a[3])) + ((b[0] + b[1]) + (b[2] + b[3])) + ((c[0] + c[1]) + (c[2] + c[3])) + ((d[0] + d[1]) + (d[2] + d[3]));
        rs[t] = 1.0f / sqrtf(s * (1.0f / 1024.0f) + 1e-6f); }
    asm volatile("s_waitcnt lgkmcnt(0)\n\ts_barrier" ::: "memory");
}

__device__ __forceinline__ void unit_rstd_conv(PG8_LAS float* rs, const float* rowsq, int pm, PG8_LAS float* ct, const float* cw, const float* cb, int pn) {
    int t = threadIdx.x; asm volatile("" : "+v"(t));
    if (t < 256) { const f32x4* rp = (const f32x4*)(rowsq + (size_t)(pm * BM + t) * 16); const f32x4 a = rp[0], b = rp[1], c = rp[2], d = rp[3];
        const float s = ((a[0] + a[1]) + (a[2] + a[3])) + ((b[0] + b[1]) + (b[2] + b[3])) + ((c[0] + c[1]) + (c[2] + c[3])) + ((d[0] + d[1]) + (d[2] + d[3]));
        rs[t] = 1.0f / sqrtf(s * (1.0f / 1024.0f) + 1e-6f); }
    else { const int j = t - 256, p = j >> 5, c4 = (j & 31) * 4; const float* srcp = ((p & 3) < 3 ? cw + (p & 3) * 5632 : cb) + (p >> 2) * 2816 + pn * 128 + c4;
        const float k = (p >> 2) ? 0.6931471805599453f : 1.4426950408889634f;
        *(PG8_LAS f32x4*)(ct + p * 128 + c4) = *(const f32x4*)srcp * k; }
    asm volatile("s_waitcnt lgkmcnt(0)\n\ts_barrier" ::: "memory");
}

struct EpiScaleBf16 {
    static constexpr bool PERM = true, AFTER_DRAIN = false;
    bf16_t* O; int ldc; const float* rowsq; PG8_LAS float* rs;
    bf16_t* HM; int hm_pn0; size_t hm_stride;
    __device__ __forceinline__ void operator()(const f32x4 (&acc)[2][2][4][2], const Unit& u, int wr, int wc, int fr, int fq) const {
        if (rowsq) unit_rstd(rs, rowsq, u.pm);
        const bool hm = HM != nullptr && u.pn >= hm_pn0; const int q = u.pn - hm_pn0;
        const unsigned vo = 2u * (hm ? (unsigned)((((wc >> 1) * 2048 + wr * 64 + fr) * 64) + 32 * (wc & 1) + 8 * fq) : (unsigned)((wr * 64 + fr) * ldc + wc * 32 + 8 * fq));
#pragma unroll
        for (int ai = 0; ai < 2; ++ai)
#pragma unroll
            for (int m = 0; m < 4; ++m) { float sc = 1.f;
                if (rowsq) sc = rs[wr * 64 + fr + ai * HALF + m * 16];
#pragma unroll
                for (int bj = 0; bj < 2; ++bj) { const f32x4 v0 = acc[ai][bj][m][0] * sc, v1 = acc[ai][bj][m][1] * sc;
                    u32x4 w; w.x = cvt_pk_bf16(v0[0], v0[1]); w.y = cvt_pk_bf16(v0[2], v0[3]); w.z = cvt_pk_bf16(v1[0], v1[1]); w.w = cvt_pk_bf16(v1[2], v1[3]);
                    const bf16_t* ob = O + (size_t)(u.pm * BM + ai * HALF + m * 16) * ldc + u.pn * BM + bj * HALF;
                    const bf16_t* hb = HM + (size_t)(q >> 1) * hm_stride + (size_t)((((u.pm >> 3) * 8 + (q & 1) * 4 + 2 * bj) * 2048) + (u.pm & 7) * 256 + ai * HALF + m * 16) * 64;
                    *(u32x4*)((char*)(hm ? hb : ob) + vo) = w; } }
    }
};
struct EpiKV {
    static constexpr bool PERM = true, AFTER_DRAIN = false;
    bf16_t* O; int ldc; const float* gq; const float* gk; PG8_LAS float* rs;
    __device__ __forceinline__ void operator()(const f32x4 (&acc)[2][2][4][2], const Unit& u, int wr, int wc, int fr, int fq) const {
        const int row0 = u.pm * BM + wr * 64 + fr; const int col0 = u.pn * BM + wc * 32 + 8 * fq; const bool isk = u.pn < 4;
        float sc[2][4]; f32x4 g[2][2];
#pragma unroll
        for (int ai = 0; ai < 2; ++ai)
#pragma unroll
            for (int m = 0; m < 4; ++m) sc[ai][m] = 1.f;
#pragma unroll
        for (int bj = 0; bj < 2; ++bj)
#pragma unroll
            for (int n = 0; n < 2; ++n) g[bj][n] = (f32x4){1.f, 1.f, 1.f, 1.f};
        if (isk) { PG8_LAS float* part = rs + 256;
#pragma unroll
            for (int ai = 0; ai < 2; ++ai)
#pragma unroll
                for (int m = 0; m < 4; ++m) { float s = 0.f;
#pragma unroll
                    for (int bj = 0; bj < 2; ++bj)
#pragma unroll
                        for (int n = 0; n < 2; ++n)
#pragma unroll
                            for (int i = 0; i < 4; ++i) s = __builtin_fmaf(acc[ai][bj][m][n][i], acc[ai][bj][m][n][i], s);
                    s += __shfl_xor(s, 16); s += __shfl_xor(s, 32);
                    if (fq == 0) part[wc * 256 + wr * 64 + fr + ai * HALF + m * 16] = s; }
            asm volatile("s_waitcnt lgkmcnt(0)\n\ts_barrier" ::: "memory");
            { int t = threadIdx.x; asm volatile("" : "+v"(t));
              if (t < 256) rs[t] = 1.0f / sqrtf(((part[t] + part[256 + t]) + (part[512 + t] + part[768 + t])) * (1.0f / 256.0f) + 1e-6f); }
            asm volatile("s_waitcnt lgkmcnt(0)\n\ts_barrier" ::: "memory");
#pragma unroll
            for (int ai = 0; ai < 2; ++ai)
#pragma unroll
                for (int m = 0; m < 4; ++m) sc[ai][m] = rs[wr * 64 + fr + ai * HALF + m * 16];
#pragma unroll
            for (int bj = 0; bj < 2; ++bj)
#pragma unroll
                for (int n = 0; n < 2; ++n) { const int c = bj * HALF + wc * 32 + 8 * fq + 4 * n; g[bj][n] = *(const f32x4*)(gq + c) * *(const f32x4*)(gk + c); } }
#pragma unroll
        for (int ai = 0; ai < 2; ++ai)
#pragma unroll
            for (int m = 0; m < 4; ++m) { const int row = row0 + ai * HALF + m * 16; bf16_t* rowp = O + (size_t)row * ldc + col0;
#pragma unroll
                for (int bj = 0; bj < 2; ++bj) { const f32x4 v0 = acc[ai][bj][m][0] * g[bj][0] * sc[ai][m], v1 = acc[ai][bj][m][1] * g[bj][1] * sc[ai][m];
                    u32x4 w; w.x = cvt_pk_bf16(v0[0], v0[1]); w.y = cvt_pk_bf16(v0[2], v0[3]); w.z = cvt_pk_bf16(v1[0], v1[1]); w.w = cvt_pk_bf16(v1[2], v1[3]);
                    *(u32x4*)(rowp + bj * HALF) = w; } }
    }
};
struct EpiRes {
    static constexpr bool PERM = true, AFTER_DRAIN = false;
    float* out; bf16_t* xb; float* rowsq; bool fin; bf16_t* xbw;
    __device__ __forceinline__ void operator()(const f32x4 (&acc)[2][2][4][2], const Unit& u, int wr, int wc, int fr, int fq) const {
        const unsigned lv = (unsigned)((wr * 64 + fr) * 1024 + wc * 32 + 8 * fq);
#define UB(ai_, m_, bj_) ((size_t)(u.pm * BM + (ai_) * HALF + (m_) * 16) * 1024 + u.pn * BM + (bj_) * HALF)
        u32x4 xv[2][4][2];
#pragma unroll
        for (int ai = 0; ai < 2; ++ai)
#pragma unroll
            for (int m = 0; m < 4; ++m)
#pragma unroll
                for (int bj = 0; bj < 2; ++bj) xv[ai][m][bj] = *(const u32x4*)((const char*)(xb + UB(ai, m, bj)) + 2u * lv);
#pragma unroll
        for (int ai = 0; ai < 2; ++ai)
#pragma unroll
            for (int m = 0; m < 4; ++m) { float s = 0.f;
#pragma unroll
                for (int bj = 0; bj < 2; ++bj) { const u32x4 b = xv[ai][m][bj];
                    f32x4 o0 = acc[ai][bj][m][0], o1 = acc[ai][bj][m][1];
                    o0[0] += __uint_as_float(b.x << 16); o0[1] += __uint_as_float(b.x & 0xffff0000u); o0[2] += __uint_as_float(b.y << 16); o0[3] += __uint_as_float(b.y & 0xffff0000u);
                    o1[0] += __uint_as_float(b.z << 16); o1[1] += __uint_as_float(b.z & 0xffff0000u); o1[2] += __uint_as_float(b.w << 16); o1[3] += __uint_as_float(b.w & 0xffff0000u);
                    if (fin) { char* op_ = (char*)(out + UB(ai, m, bj)) + 4u * lv; *(f32x4*)op_ = o0; *(f32x4*)(op_ + 16) = o1; }
                    else { u32x4 w; w.x = cvt_pk_bf16(o0[0], o0[1]); w.y = cvt_pk_bf16(o0[2], o0[3]); w.z = cvt_pk_bf16(o1[0], o1[1]); w.w = cvt_pk_bf16(o1[2], o1[3]); *(u32x4*)((char*)(xbw + UB(ai, m, bj)) + 2u * lv) = w; }
#pragma unroll
                    for (int i = 0; i < 4; ++i) s = __builtin_fmaf(o0[i], o0[i], s);
#pragma unroll
                    for (int i = 0; i < 4; ++i) s = __builtin_fmaf(o1[i], o1[i], s); }
                s += __shfl_xor(s, 16); s += __shfl_xor(s, 32);
                if (fq == 0) *(float*)((char*)(rowsq + (size_t)(u.pm * BM + ai * HALF + m * 16) * 16 + u.pn * 4) + 4u * (unsigned)((wr * 64 + fr) * 16 + wc)) = s; }
    }
#undef UB
};

struct EpiConvGlu {
    static constexpr bool PERM = true, AFTER_DRAIN = false;
    bf16_t* ACT; const float* rowsq; const float* cw; const float* cb; float* EDGE; PG8_LAS float* rs;
    static __device__ __forceinline__ f32x4 shr1(const f32x4 v) { float r0, r1, r2, r3;
        asm volatile("s_nop 4\n\tv_mov_b32_dpp %0, %4 row_shr:1 row_mask:0xf bank_mask:0xf bound_ctrl:1\n\tv_mov_b32_dpp %1, %5 row_shr:1 row_mask:0xf bank_mask:0xf bound_ctrl:1\n\t"
                     "v_mov_b32_dpp %2, %6 row_shr:1 row_mask:0xf bank_mask:0xf bound_ctrl:1\n\tv_mov_b32_dpp %3, %7 row_shr:1 row_mask:0xf bank_mask:0xf bound_ctrl:1"
                     : "=&v"(r0), "=&v"(r1), "=&v"(r2), "=&v"(r3) : "v"(v[0]), "v"(v[1]), "v"(v[2]), "v"(v[3]));
        return (f32x4){r0, r1, r2, r3}; }
    __device__ __forceinline__ void operator()(f32x4 (&acc)[2][2][4][2], const Unit& u, int wr, int wc, int fr, int fq) const {
        const unsigned alv = (unsigned)(8 * (fr + 16 * wr) * 2816 + wc * 32 + 8 * fq);
        PG8_LAS float* ct = rs + 256; unit_rstd_conv(rs, rowsq, u.pm, ct, cw, cb, u.pn); const int cl = wc * 32 + 8 * fq;
        const f32x4 sc0 = *(const PG8_LAS f32x4*)(rs + 8 * (fr + 16 * wr)), sc1 = *(const PG8_LAS f32x4*)(rs + 8 * (fr + 16 * wr) + 4);
#pragma unroll
        for (int ai = 0; ai < 2; ++ai)
#pragma unroll
            for (int m = 0; m < 4; ++m) { const float sc = ai ? sc1[m] : sc0[m];
#pragma unroll
                for (int bj = 0; bj < 2; ++bj)
#pragma unroll
                    for (int n = 0; n < 2; ++n) acc[ai][bj][m][n] = acc[ai][bj][m][n] * sc; }
        { const unsigned elv = 4u * (unsigned)(wr * 4 * 5632 + wc * 32 + 8 * fq); float* const eu = EDGE + (size_t)(2 * u.pm) * 4 * 5632 + u.pn * BM;
#define ep_at(o_) ((char*)(eu + (o_)) + elv)
          if (fr == 0) {
#pragma unroll
              for (int bj = 0; bj < 2; ++bj)
#pragma unroll
                  for (int n = 0; n < 2; ++n) { *(f32x4*)ep_at(bj * HALF + 4 * n) = acc[0][bj][0][n]; *(f32x4*)ep_at(5632 + bj * HALF + 4 * n) = acc[0][bj][1][n]; }
              asm volatile("; strip-head rows stored" ::: "memory"); }
          if (fr == 15) {
#pragma unroll
              for (int bj = 0; bj < 2; ++bj)
#pragma unroll
                  for (int n = 0; n < 2; ++n) { *(f32x4*)ep_at(2 * 5632 + bj * HALF + 4 * n) = acc[1][bj][2][n]; *(f32x4*)ep_at(3 * 5632 + bj * HALF + 4 * n) = acc[1][bj][3][n]; }
              asm volatile("; strip-tail rows stored" ::: "memory"); } }
#undef ep_at
#pragma unroll
        for (int n = 0; n < 2; ++n) { asm volatile("" ::: "memory");
            const PG8_LAS float* cp = ct + cl + 4 * n;
            const f32x4 g0 = *(const PG8_LAS f32x4*)(cp), g1 = *(const PG8_LAS f32x4*)(cp + 128), g2 = *(const PG8_LAS f32x4*)(cp + 256), gb = *(const PG8_LAS f32x4*)(cp + 384);
            const f32x4 u0 = *(const PG8_LAS f32x4*)(cp + 512), u1 = *(const PG8_LAS f32x4*)(cp + 640), u2 = *(const PG8_LAS f32x4*)(cp + 768), ub = *(const PG8_LAS f32x4*)(cp + 896);
            const f32x4 gh1 = shr1(acc[1][0][3][n]), gh2 = shr1(acc[1][0][2][n]), uh1 = shr1(acc[1][1][3][n]), uh2 = shr1(acc[1][1][2][n]);
#pragma unroll
            for (int k = 0; k < 8; ++k) { const f32x4 gv = acc[k >> 2][0][k & 3][n], uv = acc[k >> 2][1][k & 3][n];
                const f32x4 gm1 = (k >= 1) ? acc[(k - 1) >> 2][0][(k - 1) & 3][n] : gh1, um1 = (k >= 1) ? acc[(k - 1) >> 2][1][(k - 1) & 3][n] : uh1;
                const f32x4 gm2 = (k >= 2) ? acc[(k - 2) >> 2][0][(k - 2) & 3][n] : (k == 1 ? gh1 : gh2), um2 = (k >= 2) ? acc[(k - 2) >> 2][1][(k - 2) & 3][n] : (k == 1 ? uh1 : uh2);
                f32x4 gg, uu, a, e;
#pragma unroll
                for (int i = 0; i < 4; ++i) { gg[i] = __builtin_fmaf(g2[i], gv[i], __builtin_fmaf(g1[i], gm1[i], __builtin_fmaf(g0[i], gm2[i], gb[i]))); uu[i] = __builtin_fmaf(u2[i], uv[i], __builtin_fmaf(u1[i], um1[i], __builtin_fmaf(u0[i], um2[i], ub[i]))); }
#pragma unroll
                for (int i = 0; i < 4; ++i) e[i] = __builtin_amdgcn_exp2f(-gg[i]);
#pragma unroll
                for (int i = 0; i < 4; ++i) { e[i] = 1.0f + e[i]; uu[i] *= gg[i]; }
#pragma unroll
                for (int i = 0; i < 4; ++i) e[i] = __builtin_amdgcn_rcpf(e[i]);
#pragma unroll
                for (int i = 0; i < 4; ++i) a[i] = uu[i] * e[i];
                typedef unsigned u32x2v __attribute__((ext_vector_type(2))); u32x2v w; w.x = cvt_pk_bf16(a[0], a[1]); w.y = cvt_pk_bf16(a[2], a[3]);
                *(u32x2v*)((char*)(ACT + (size_t)(u.pm * BM + k) * 2816 + u.pn * 128 + 4 * n) + 2u * alv) = w; } }
    }
};

template <class Epi, class Sched, bool ALIGN_EPI = false, bool SP2 = false, bool APERM = false>
__device__ __forceinline__ void gemm_phase(PG8_LAS unsigned char* lds, const Gemm g, const Sched& S, const Epi& E) {
    int tid_ = threadIdx.x; asm volatile("" : "+v"(tid_));
    const int tid = tid_, wid = __builtin_amdgcn_readfirstlane(tid >> 6), lane = tid & 63, wr = wid >> 2, wc = wid & 3, fr = lane & 15, fq = lane >> 4;
    const int K = g.K, nt = K / BK;
    unsigned voffA[2], voffB[2];
#pragma unroll
    for (int i = 0; i < 2; ++i) { int R, C; stage_rc(tid * 16 + i * 8192, R, C); const int Rb = Epi::PERM ? ((R & ~31) + perm32(R & 31)) : R;
        const int Ra = APERM ? (8 * ((R & 15) + 16 * ((R >> 6) & 1)) + ((R >> 4) & 3)) : R; voffA[i] = (unsigned)(Ra * K + C) * 2u; voffB[i] = (unsigned)(Rb * K + C) * 2u; }
    const size_t kstep = (size_t)(BK * 2);
    const size_t hstep = (size_t)HALF * K * 2;
    const size_t hstepA = APERM ? (size_t)4 * K * 2 : hstep;
    const size_t tstep = 2 * hstep;
    const unsigned ldsw = (unsigned)wid * 1024u;
    const int aoff = lds_byte(wr * 64 + fr, fq * 8), boff = lds_byte(wc * 32 + fr, fq * 8);
#define PG8_SA(b, h) (((b) * 2 + (h)) * HTB)
#define PG8_SB(b, h) ((4 + (b) * 2 + (h)) * HTB)
#define PG8_STAGE(bufoff, gbase, voff) do { _Pragma("unroll") for (int _i = 0; _i < 2; ++_i) \
        __builtin_amdgcn_global_load_lds((const unsigned*)((const char*)(gbase) + (voff)[_i]), (PG8_LAS unsigned*)(lds + (bufoff) + ldsw + _i * 8192), 16, 0, 0); } while (0)
#define PG8_LDA(dst, b, h) do { _Pragma("unroll") for (int m = 0; m < 4; ++m) _Pragma("unroll") for (int k = 0; k < 2; ++k) dst[m][k] = *(const PG8_LAS bf16x8*)(lds + PG8_SA(b, h) + aoff + m * 2048 + k * 1024); } while (0)
#define PG8_LDB(dst, b, h) do { _Pragma("unroll") for (int n = 0; n < 2; ++n) _Pragma("unroll") for (int k = 0; k < 2; ++k) dst[n][k] = *(const PG8_LAS bf16x8*)(lds + PG8_SB(b, h) + boff + n * 2048 + k * 1024); } while (0)
#define PG8_MMA_BODY(ai, bj, At, Bt) _Pragma("unroll") for (int m = 0; m < 4; ++m) _Pragma("unroll") for (int q = 0; q < 4; ++q) { const int e = (m & 1) ? 3 - q : q, n = e >> 1, k = (e & 1) ^ (e >> 1); \
        acc[ai][bj][m][n] = __builtin_amdgcn_mfma_f32_16x16x32_bf16(Bt[n][k], At[m][k], acc[ai][bj][m][n], 0, 0, 0); __builtin_amdgcn_sched_barrier(0); }
#define PG8_MMAR_BODY(ai, bj, At, Bt) _Pragma("unroll") for (int mi = 0; mi < 4; ++mi) _Pragma("unroll") for (int q = 0; q < 4; ++q) { const int m = 3 - mi, e = (mi & 1) ? 3 - q : q, n = e >> 1, k = (e & 1) ^ (e >> 1); \
        acc[ai][bj][m][n] = __builtin_amdgcn_mfma_f32_16x16x32_bf16(Bt[n][k], At[m][k], acc[ai][bj][m][n], 0, 0, 0); __builtin_amdgcn_sched_barrier(0); }
#define PG8_MMA(ai, bj, At, Bt) do { __builtin_amdgcn_s_setprio(1); PG8_MMA_BODY(ai, bj, At, Bt) __builtin_amdgcn_s_setprio(0); } while (0)
#define PG8_MMAR(ai, bj, At, Bt) do { __builtin_amdgcn_s_setprio(1); PG8_MMAR_BODY(ai, bj, At, Bt) __builtin_amdgcn_s_setprio(0); } while (0)
#define PG8_MMA2(ai, At, Ba, Bb) do { __builtin_amdgcn_s_setprio(1); PG8_MMA_BODY(ai, 0, At, Ba) PG8_MMAR_BODY(ai, 1, At, Bb) __builtin_amdgcn_s_setprio(0); } while (0)
#define PG8_WAIT_V(n) asm volatile("s_waitcnt vmcnt(" #n ")" ::: "memory")
#define PG8_WAIT_L(n) asm volatile("s_waitcnt lgkmcnt(" #n ")" ::: "memory")
#define PG8_BAR __builtin_amdgcn_s_barrier()
#define PG8_SCHED __builtin_amdgcn_sched_barrier(0)
    Unit cur, nxt; int ui = 0;
    if (!S.next(0, cur)) return;
    f32x4 acc[2][2][4][2];
#pragma unroll
    for (int a = 0; a < 2; ++a)
#pragma unroll
        for (int b = 0; b < 2; ++b)
#pragma unroll
            for (int m = 0; m < 4; ++m)
#pragma unroll
                for (int n = 0; n < 2; ++n) acc[a][b][m][n] = (f32x4){0.f, 0.f, 0.f, 0.f};
    bf16x8 At[4][2], B0[2][2], B1[2][2];
    const char* cA = (const char*)g.A + (size_t)cur.pm * tstep; const char* cB = (const char*)g.Bt + (size_t)cur.pn * tstep;
    S.a_ready(cur);
    if constexpr (SP2) {
        PG8_STAGE(PG8_SB(0, 0), cB, voffB); PG8_STAGE(PG8_SB(0, 1), cB + hstep, voffB); PG8_STAGE(PG8_SA(0, 0), cA, voffA); PG8_STAGE(PG8_SA(0, 1), cA + hstepA, voffA);
        if (wr == 1) PG8_BAR;
        PG8_WAIT_V(2); PG8_BAR;
        PG8_STAGE(PG8_SB(1, 0), cB + kstep, voffB); PG8_STAGE(PG8_SA(1, 0), cA + kstep, voffA); PG8_STAGE(PG8_SB(1, 1), cB + hstep + kstep, voffB);
        PG8_WAIT_V(6); PG8_BAR;
    } else {
        PG8_STAGE(PG8_SB(0, 0), cB, voffB); PG8_STAGE(PG8_SA(0, 0), cA, voffA); PG8_STAGE(PG8_SB(0, 1), cB + hstep, voffB); PG8_STAGE(PG8_SA(0, 1), cA + hstepA, voffA);
        if (wr == 1) PG8_BAR;
        PG8_WAIT_V(4); PG8_BAR;
        PG8_STAGE(PG8_SB(1, 0), cB + kstep, voffB); PG8_STAGE(PG8_SA(1, 0), cA + kstep, voffA); PG8_STAGE(PG8_SB(1, 1), cB + hstep + kstep, voffB);
        PG8_WAIT_V(6); PG8_BAR;
    }
    for (;;) {
        const bool has_next = S.next(ui + 1, nxt);
        const char* nA = has_next ? (const char*)g.A + (size_t)nxt.pm * tstep : cA; const char* nB = has_next ? (const char*)g.Bt + (size_t)nxt.pn * tstep : cB;
        for (int t = 0; t < nt; t += 2) {
            const bool last = (t == nt - 2);
            const char* a1 = cA + (size_t)(t + 1) * kstep;
            const char* a2 = last ? nA : cA + (size_t)(t + 2) * kstep; const char* b2 = last ? nB : cB + (size_t)(t + 2) * kstep;
            const char* a3 = a2 + kstep; const char* b3 = b2 + kstep;
            if (last && has_next) S.a_ready(nxt);
            if constexpr (SP2) {
            PG8_LDB(B0, 0, 0); PG8_LDB(B1, 0, 1); PG8_SCHED; PG8_LDA(At, 0, 0); PG8_STAGE(PG8_SA(1, 1), a1 + hstepA, voffA);
            PG8_WAIT_V(8); PG8_WAIT_L(0); PG8_BAR; PG8_MMA2(0, At, B0, B1); PG8_BAR; PG8_SCHED;
            PG8_LDA(At, 0, 1); PG8_STAGE(PG8_SB(0, 0), b2, voffB); PG8_STAGE(PG8_SB(0, 1), b2 + hstep, voffB); PG8_STAGE(PG8_SA(0, 0), a2, voffA);
            PG8_WAIT_V(8); PG8_WAIT_L(0); PG8_BAR; PG8_MMA2(1, At, B0, B1); PG8_BAR; PG8_SCHED;
            PG8_LDB(B0, 1, 0); PG8_LDB(B1, 1, 1); PG8_SCHED; PG8_LDA(At, 1, 0); PG8_STAGE(PG8_SA(0, 1), a2 + hstepA, voffA);
            PG8_WAIT_V(8); PG8_WAIT_L(0); PG8_BAR; PG8_MMA2(0, At, B0, B1); PG8_BAR; PG8_SCHED;
            PG8_LDA(At, 1, 1); PG8_STAGE(PG8_SB(1, 0), b3, voffB); PG8_STAGE(PG8_SB(1, 1), b3 + hstep, voffB); PG8_STAGE(PG8_SA(1, 0), a3, voffA);
            PG8_WAIT_V(8); PG8_WAIT_L(0); PG8_BAR; PG8_MMA2(1, At, B0, B1); PG8_BAR; PG8_SCHED;
            } else {
            PG8_LDB(B0, 0, 0); PG8_SCHED; PG8_LDA(At, 0, 0); PG8_STAGE(PG8_SA(1, 1), a1 + hstepA, voffA);
            PG8_WAIT_L(8); PG8_BAR; PG8_WAIT_L(0); PG8_MMA(0, 0, At, B0); PG8_BAR; PG8_SCHED;
            PG8_LDB(B1, 0, 1); PG8_STAGE(PG8_SB(0, 0), b2, voffB);
            PG8_BAR; PG8_WAIT_L(0); PG8_MMA(0, 1, At, B1); PG8_BAR;
            PG8_LDA(At, 0, 1); PG8_STAGE(PG8_SA(0, 0), a2, voffA);
            PG8_BAR; PG8_WAIT_L(0); PG8_MMA(1, 0, At, B0); PG8_BAR; PG8_SCHED;
            PG8_STAGE(PG8_SB(0, 1), b2 + hstep, voffB);
            PG8_WAIT_V(6); PG8_BAR; PG8_MMA(1, 1, At, B1); PG8_BAR;
            PG8_LDB(B0, 1, 0); PG8_SCHED; PG8_LDA(At, 1, 0); PG8_STAGE(PG8_SA(0, 1), a2 + hstepA, voffA);
            PG8_WAIT_L(8); PG8_BAR; PG8_WAIT_L(0); PG8_MMA(0, 0, At, B0); PG8_BAR; PG8_SCHED;
            PG8_LDB(B1, 1, 1); PG8_STAGE(PG8_SB(1, 0), b3, voffB);
            PG8_BAR; PG8_WAIT_L(0); PG8_MMA(0, 1, At, B1); PG8_BAR;
            PG8_LDA(At, 1, 1); PG8_STAGE(PG8_SA(1, 0), a3, voffA);
            PG8_BAR; PG8_WAIT_L(0); PG8_MMA(1, 0, At, B0); PG8_BAR; PG8_SCHED;
            PG8_STAGE(PG8_SB(1, 1), b3 + hstep, voffB);
            PG8_WAIT_V(6); PG8_BAR; PG8_MMA(1, 1, At, B1); PG8_BAR;
            }
        }
        if constexpr (ALIGN_EPI) { if (wr == 0) PG8_BAR; }
        if constexpr (!Epi::AFTER_DRAIN) { E(acc, cur, wr, wc, fr, fq); S.done(cur); }
        if (!has_next) break;
#pragma unroll
        for (int a = 0; a < 2; ++a)
#pragma unroll
            for (int b = 0; b < 2; ++b)
#pragma unroll
                for (int m = 0; m < 4; ++m)
#pragma unroll
                    for (int n = 0; n < 2; ++n) acc[a][b][m][n] = (f32x4){0.f, 0.f, 0.f, 0.f};
        cur = nxt; cA = nA; cB = nB; ++ui;
        if constexpr (ALIGN_EPI) { if (wr == 1) PG8_BAR; }
    }
    PG8_WAIT_V(0);
    if constexpr (!ALIGN_EPI) { if (wr == 0) PG8_BAR; }
    PG8_BAR;
    if constexpr (Epi::AFTER_DRAIN) { E.fused(acc, cur, wr, wc, fr, fq, lds, wid, lane); S.done(cur); }
#undef PG8_SA
#undef PG8_SB
#undef PG8_STAGE
#undef PG8_LDA
#undef PG8_LDB
#undef PG8_MMA
#undef PG8_MMAR
#undef PG8_MMA2
#undef PG8_MMA_BODY
#undef PG8_MMAR_BODY
#undef PG8_WAIT_V
#undef PG8_WAIT_L
#undef PG8_BAR
#undef PG8_SCHED
}
}
constexpr int NWAVES = 8;
constexpr int NB = 32, SEQ = 2048, DM = 1024, M = NB * SEQ, NMEM = 256, MM = NB * NMEM;
constexpr int AB_IN = 2304, HG_IN = 4096, DFF = 2816, UPN = 2 * DFF, MH = M / 2;
constexpr float EPS = 1e-6f;
constexpr size_t MiB = 1u << 20;
constexpr size_t WS_CTL = 0, CTL_ZERO_BYTES = 1 * MiB;
constexpr size_t WS_ROWSQ = 2 * MiB;
constexpr size_t WS_LBV = 6 * MiB;
constexpr size_t WS_OSQ = 7 * MiB;
constexpr size_t WS_ROPE = 11 * MiB;
constexpr size_t WS_MEMB = 27 * MiB;
constexpr size_t WS_KV = 43 * MiB;
constexpr size_t WS_W = 75 * MiB;
constexpr size_t WS_XB = 206 * MiB;
constexpr size_t WS_BIG = 334 * MiB;
constexpr size_t WS_HM = 622 * MiB;
constexpr size_t WS_AO = 846 * MiB;
constexpr size_t WS_ACT = WS_BIG;
constexpr size_t WS_EDGE = 686 * MiB;
constexpr size_t WS_END = 974 * MiB;
constexpr size_t W_ABIN = 0, W_ABOUT = 4718592, W_HGIN = 6815744, W_HGOUT = 15204352, W_XQ = 17301504, W_XKV = 21495808, W_XO = 29884416, W_UP = 34078720, W_DOWN = 57147392, W_TOTAL = 68681728;
static_assert(WS_W + W_TOTAL * 2 <= WS_XB && WS_BIG + (size_t)M * HG_IN * 2 <= WS_AO && WS_ACT + (size_t)M * DFF * 2 <= WS_EDGE && WS_EDGE + (size_t)(M / 128) * 4 * UPN * 4 <= WS_AO, "ws map");
static_assert(WS_BIG + (size_t)M * AB_IN * 2 <= WS_HM && WS_HM + (size_t)2 * M * 512 * 2 <= WS_AO, "ws map: head-major K/V");
constexpr int CW_BAR = 4096;
constexpr int RING_BYTES = 131072, LDSCTL_OFF = RING_BYTES, MISC_OFF = LDSCTL_OFF + 320, LDS_BYTES = 147456;

#define GAS __attribute__((address_space(1)))
#define LAS __attribute__((address_space(3)))
typedef unsigned short bf16;
typedef unsigned v4u __attribute__((ext_vector_type(4)));
typedef unsigned v2u __attribute__((ext_vector_type(2)));
typedef float f32x4 __attribute__((ext_vector_type(4)));
typedef float f32x2 __attribute__((ext_vector_type(2)));
typedef GAS unsigned gu32;
#define RLX_AGENT __ATOMIC_RELAXED, __HIP_MEMORY_SCOPE_AGENT
#define LDS_WAIT() asm volatile("s_waitcnt lgkmcnt(0)" ::: "memory")
__device__ __forceinline__ unsigned f2bf(float f) { unsigned u = __builtin_bit_cast(unsigned, f); return (u + 0x7fffu + ((u >> 16) & 1u)) >> 16; }
__device__ __forceinline__ unsigned pk2(float lo, float hi) { return f2bf(lo) | (f2bf(hi) << 16); }
__device__ __forceinline__ float bflo(unsigned w) { return __uint_as_float(w << 16); }
__device__ __forceinline__ float bfhi(unsigned w) { return __uint_as_float(w & 0xffff0000u); }
__device__ __forceinline__ float bf2f(bf16 h) { return __uint_as_float(((unsigned)h) << 16); }
__device__ __forceinline__ void unpack8(const v4u w, float* f) { f[0] = bflo(w.x); f[1] = bfhi(w.x); f[2] = bflo(w.y); f[3] = bfhi(w.y); f[4] = bflo(w.z); f[5] = bfhi(w.z); f[6] = bflo(w.w); f[7] = bfhi(w.w); }
__device__ __forceinline__ v4u pack8(const float* f) { v4u w; w.x = pk2(f[0], f[1]); w.y = pk2(f[2], f[3]); w.z = pk2(f[4], f[5]); w.w = pk2(f[6], f[7]); return w; }
__device__ __forceinline__ float wave_sum(float v) {
#pragma unroll
    for (int o = 1; o < 64; o <<= 1) v += __shfl_xor(v, o);
    return v;
}
__device__ __forceinline__ float wave_max(float v) {
#pragma unroll
    for (int o = 1; o < 64; o <<= 1) v = fmaxf(v, __shfl_xor(v, o));
    return v;
}
#define XB_TMO      128
#define XB_XCNT(j)  (256  + 64 * (j))
#define XB_XSUB(j)  (1280 + 64 * (j))
#define XB_XGEN(j)  (2304 + 64 * (j))
#define XB_TOP      3328
#define XB_TOPGEN   3392
#define XCD_BAR_WORDS 3456
#define XB_SPIN_CAP (1u << 18)

__device__ __forceinline__ unsigned xb_ld(unsigned* p)              { return __hip_atomic_load(p, __ATOMIC_RELAXED, __HIP_MEMORY_SCOPE_AGENT); }
__device__ __forceinline__ unsigned xb_add(unsigned* p, unsigned v) { return __hip_atomic_fetch_add(p, v, __ATOMIC_RELAXED, __HIP_MEMORY_SCOPE_AGENT); }
__device__ __forceinline__ unsigned xb_xcc_id() { return (unsigned)__builtin_amdgcn_s_getreg((3 << 11) | 20) & 0xFu; }
#define XB_SPIN(cond, bar) do { unsigned _sp = 0; while (cond) { __builtin_amdgcn_s_sleep(1); \
    if ((++_sp & 255u) == 0u) { if (xb_ld(&(bar)[XB_TMO])) break; if (_sp > XB_SPIN_CAP) { atomicAdd(&(bar)[XB_TMO], 1u); break; } } } } while (0)

struct XcdBarrier {
    unsigned* bar; unsigned x;
    volatile LAS unsigned* st;
};

__device__ __forceinline__ XcdBarrier xcd_barrier_post(unsigned* bar, volatile LAS unsigned* st) {
    XcdBarrier b; b.bar = bar; b.x = xb_xcc_id(); b.st = st;
    if (threadIdx.x == 0) (void)xb_add(&bar[XB_XCNT(b.x)], 1u);
    return b;
}
__device__ __forceinline__ void xcd_barrier_complete(unsigned* bar, unsigned x, unsigned& nloc, unsigned& nx) {
    const unsigned G = gridDim.x * gridDim.y * gridDim.z;
    unsigned sum, cnt, mine, sp = 0u;
    for (;;) {
        sum = 0u; cnt = 0u; mine = 0u;
#pragma unroll
        for (unsigned j = 0; j < 16; ++j) { const unsigned c = xb_ld(&bar[XB_XCNT(j)]); sum += c; cnt += (c > 0u) ? 1u : 0u; mine = (j == x) ? c : mine; }
        if (sum == G) break;
        __builtin_amdgcn_s_sleep(1);
        if ((++sp & 255u) == 0u) { if (xb_ld(&bar[XB_TMO])) break; if (sp > XB_SPIN_CAP) { atomicAdd(&bar[XB_TMO], 1u); break; } }
    }
    nloc = mine > 0u ? mine : 1u; nx = cnt > 0u ? cnt : 1u;
}

__device__ __attribute__((noinline)) void xcd_barrier(const XcdBarrier b) {
    asm volatile("s_waitcnt vmcnt(0)" ::: "memory");
    __syncthreads();
    if (threadIdx.x == 0) {
        unsigned* bar = b.bar;
        __builtin_amdgcn_s_waitcnt(0);
        unsigned nloc = b.st[0], nx = b.st[1];
        if (nloc == 0u) { xcd_barrier_complete(bar, b.x, nloc, nx); b.st[0] = nloc; b.st[1] = nx; }
        const unsigned old = xb_add(&bar[XB_XSUB(b.x)], 1u);
        const unsigned gen = old / nloc;
        if (old + 1u == (gen + 1u) * nloc) {
            __builtin_amdgcn_fence(__ATOMIC_RELEASE, "agent");
            asm volatile("s_waitcnt vmcnt(0)" ::: "memory");
            const unsigned og = xb_add(&bar[XB_TOP], 1u);
            const unsigned tg = og / nx;
            if (og + 1u == (tg + 1u) * nx) xb_add(&bar[XB_TOPGEN], 1u);
            else XB_SPIN(xb_ld(&bar[XB_TOPGEN]) == tg, bar);
            __builtin_amdgcn_fence(__ATOMIC_ACQUIRE, "agent");
            xb_add(&bar[XB_XGEN(b.x)], 1u);
            asm volatile("s_waitcnt vmcnt(0)" ::: "memory");
        } else {
            XB_SPIN(xb_ld(&bar[XB_XGEN(b.x)]) == gen, bar);
            __builtin_amdgcn_fence(__ATOMIC_ACQUIRE, "agent");
            asm volatile("s_waitcnt vmcnt(0)" ::: "memory");
        }
    }
    __syncthreads();
}
struct Frame {
    LAS unsigned char* lds; volatile LAS unsigned* MISC; gu32* ctl;
    int tid, lane, wave, vcu, G, gw, NGW, gtid, NT;
};
__device__ __forceinline__ Frame fresh(const Frame&) { extern __shared__ __attribute__((aligned(16))) unsigned char lds_[]; Frame F; int t = threadIdx.x; asm volatile("" : "+v"(t)); int bx = blockIdx.x; asm volatile("" : "+s"(bx));
    F.lds = (LAS unsigned char*)lds_; F.MISC = nullptr; F.ctl = nullptr; F.G = gridDim.x; F.vcu = (F.G % 8 == 0) ? (bx % 8) * (F.G / 8) + bx / 8 : bx; F.wave = __builtin_amdgcn_readfirstlane(t >> 6);
    F.NGW = F.G * NWAVES; F.NT = F.G * NWAVES * 64; F.tid = t; F.lane = t & 63; F.gw = F.vcu * NWAVES + F.wave; F.gtid = F.vcu * (NWAVES * 64) + t; return F; }

__device__ __forceinline__ void p0_transpose_item(const float* W, int K, int N, bf16* WT, LAS float* scr, int item, int lane, const float* gain, int mode) {
    const int nblk = N / 32, kb = item / nblk, nb = item % nblk, k0 = 64 * kb, n0 = 32 * nb;
    float wv[32], gv[32];
#pragma unroll
    for (int i = 0; i < 32; ++i) { const int kk = 2 * i + (lane >> 5); wv[i] = W[(size_t)(k0 + kk) * N + n0 + (lane & 31)]; gv[i] = gain ? gain[k0 + kk] : 1.f; }
#pragma unroll
    for (int i = 0; i < 32; ++i) { const int kk = 2 * i + (lane >> 5); scr[kk * 33 + (lane & 31)] = wv[i] * gv[i]; }
    LDS_WAIT(); asm volatile("" ::: "memory");
    int rbase = n0; if (mode == 1) { const int isup = n0 >= DFF ? 1 : 0; const int c = n0 - isup * DFF; rbase = (c / 128) * 256 + isup * 128 + (c % 128); }
    const int c = lane & 7;
#pragma unroll
    for (int j = 0; j < 4; ++j) { const int n = (lane >> 3) + 8 * j; const LAS float* s = scr + (8 * c) * 33 + n;
        v4u o; o.x = pk2(s[0 * 33], s[1 * 33]); o.y = pk2(s[2 * 33], s[3 * 33]); o.z = pk2(s[4 * 33], s[5 * 33]); o.w = pk2(s[6 * 33], s[7 * 33]);
        *(v4u*)(WT + (size_t)(rbase + n) * K + k0 + 8 * c) = o; }
    LDS_WAIT(); asm volatile("" ::: "memory");
}
__device__ __forceinline__ void p0_weights(Frame& F, const float* W, int cnt, int K, int N, bf16* WT, const float* gain, int gain_stride, int mode) {
    LAS float* scr = (LAS float*)(F.lds + F.wave * 16384);
    const int per = (K / 64) * (N / 32);
    for (int it = F.gw; it < cnt * per; it += F.NGW) { const int i = it / per, r = it % per;
        p0_transpose_item(W + (size_t)i * K * N, K, N, WT + (size_t)i * K * N, scr, r, F.lane, gain ? gain + (size_t)i * gain_stride : nullptr, mode); }
}
__device__ __forceinline__ void sincos_rev(double rev, float& s, float& c) {
    const double q = floor(rev * 4.0 + 0.5); const double r = (rev - q * 0.25) * 6.283185307179586476925; const double r2 = r * r;
    const double sn = r * (1.0 + r2 * (-1.0 / 6 + r2 * (1.0 / 120 + r2 * (-1.0 / 5040 + r2 * (1.0 / 362880 + r2 * (-1.0 / 39916800))))));
    const double cs = 1.0 + r2 * (-0.5 + r2 * (1.0 / 24 + r2 * (-1.0 / 720 + r2 * (1.0 / 40320 + r2 * (-1.0 / 3628800 + r2 * (1.0 / 479001600))))));
    const int qi = ((int)q) & 3;
    const double ss = (qi == 0) ? sn : (qi == 1) ? cs : (qi == 2) ? -sn : -cs;
    const double cc = (qi == 0) ? cs : (qi == 1) ? -sn : (qi == 2) ? -cs : sn;
    s = (float)ss; c = (float)cc;
}
typedef const __attribute__((address_space(4))) unsigned char* kaptr_t;
__device__ __forceinline__ const void* in_ptr(int i) { kaptr_t ka = (kaptr_t)__builtin_amdgcn_kernarg_segment_ptr(); asm volatile("" : "+s"(ka)); return *(const void* const __attribute__((address_space(4)))*)(ka + 8 * i); }
#define INF(i) ((const float*)in_ptr(i))
#define OUTP() ((float*)in_ptr(25))
#define WSP() ((unsigned char*)in_ptr(26))
enum { I_X = 0, I_MEM, I_POS, I_NORM_MIX, I_NORM_CROSS, I_NORM_MEM, I_NORM_FFN, I_AB_W_IN, I_AB_W_OUT, I_SWA_Q_NORM, I_SWA_K_NORM, I_SWA_SINKS, I_HGRN_W_IN, I_HGRN_W_OUT, I_HGRN_O_NORM, I_HGRN_LB,
       I_XA_W_Q, I_XA_W_KV, I_XA_W_O, I_XA_Q_NORM, I_XA_K_NORM, I_FFN_W_UP, I_FFN_CONV_W, I_FFN_CONV_B, I_FFN_W_DOWN };
__device__ __forceinline__ void p0_prologue(const Frame& F0) {
    unsigned char* ws = WSP();
    Frame F = fresh(F0);
    bf16* W = (bf16*)(ws + WS_W);
    p0_weights(F, INF(I_AB_W_IN), 2, DM, AB_IN, W + W_ABIN, INF(I_NORM_MIX), 2 * DM, 0);
    p0_weights(F, INF(I_AB_W_OUT), 2, DM, DM, W + W_ABOUT, nullptr, 0, 0);
    p0_weights(F, INF(I_HGRN_W_IN), 2, DM, HG_IN, W + W_HGIN, INF(I_NORM_MIX) + DM, 2 * DM, 0);
    p0_weights(F, INF(I_HGRN_W_OUT), 2, DM, DM, W + W_HGOUT, nullptr, 0, 0);
    p0_weights(F, INF(I_XA_W_Q), 4, DM, DM, W + W_XQ, INF(I_NORM_CROSS), DM, 0);
    p0_weights(F, INF(I_XA_W_KV), 4, DM, 2 * DM, W + W_XKV, INF(I_NORM_MEM), DM, 0);
    p0_weights(F, INF(I_XA_W_O), 4, DM, DM, W + W_XO, nullptr, 0, 0);
    p0_weights(F, INF(I_FFN_W_UP), 4, DM, UPN, W + W_UP, INF(I_NORM_FFN), DM, 1);
    p0_weights(F, INF(I_FFN_W_DOWN), 4, DFF, DM, W + W_DOWN, nullptr, 0, 0);
    bf16* XB = (bf16*)(ws + WS_XB); float* ROWSQ = (float*)(ws + WS_ROWSQ); const float* xin = INF(I_X);
    for (int m0 = F.gw * 4; m0 < M; m0 += F.NGW * 4) {
        f32x4 v[4][4];
#pragma unroll
        for (int r = 0; r < 4; ++r) { const f32x4* xr = (const f32x4*)(xin + (size_t)(m0 + r) * DM) + F.lane;
#pragma unroll
            for (int j = 0; j < 4; ++j) v[r][j] = xr[64 * j]; }
#pragma unroll
        for (int r = 0; r < 4; ++r) { float s = 0.f; v2u* o8 = (v2u*)(XB + (size_t)(m0 + r) * DM) + F.lane;
#pragma unroll
            for (int j = 0; j < 4; ++j) { const f32x4 t = v[r][j]; s += (t.x * t.x + t.y * t.y) + (t.z * t.z + t.w * t.w); v2u w; w.x = pk2(t.x, t.y); w.y = pk2(t.z, t.w); o8[64 * j] = w; }
            s = wave_sum(s); if (F.lane < 16) ROWSQ[(size_t)(m0 + r) * 16 + F.lane] = (F.lane == 0) ? s : 0.f; } }
    bf16* MEMB = (bf16*)(ws + WS_MEMB); const float* memin = INF(I_MEM);
    for (int m = F.gw; m < MM; m += F.NGW) { const f32x4* xr = (const f32x4*)(memin + (size_t)m * DM) + F.lane; float s = 0.f; f32x4 v[4]; v2u* o8 = (v2u*)(MEMB + (size_t)m * DM) + F.lane;
#pragma unroll
        for (int j = 0; j < 4; ++j) { v[j] = xr[64 * j]; s += (v[j].x * v[j].x + v[j].y * v[j].y) + (v[j].z * v[j].z + v[j].w * v[j].w); }
        const float r = 1.0f / sqrtf(wave_sum(s) * (1.0f / DM) + EPS);
#pragma unroll
        for (int j = 0; j < 4; ++j) { v2u w; w.x = pk2(v[j].x * r, v[j].y * r); w.y = pk2(v[j].z * r, v[j].w * r); o8[64 * j] = w; } }
    f32x2* ROPE = (f32x2*)(ws + WS_ROPE); const int* posp = (const int*)in_ptr(I_POS);
    for (int idx = F.gtid; idx < M * 32; idx += F.NT) { const int tok = idx >> 5, i = idx & 31;
        const float inv = (float)exp(-(double)i * (9.210340371976182736 / 32.0)); const float ang = (float)posp[tok] * inv;
        double rev = (double)ang * 0.15915494309189533577; rev -= floor(rev); float s, c; sincos_rev(rev, s, c); ROPE[idx] = (f32x2){c, s}; }
    float* LBV = (float*)(ws + WS_LBV); const float* hlb = INF(I_HGRN_LB);
    for (int c = F.gtid; c < DM; c += F.NT) { const float a0 = hlb[c], a1 = hlb[DM + c], a2 = hlb[2 * DM + c], a3 = hlb[3 * DM + c];
        const float mx = fmaxf(fmaxf(a0, a1), fmaxf(a2, a3)); const float e0 = expf(a0 - mx), e1 = expf(a1 - mx), e2 = expf(a2 - mx), e3 = expf(a3 - mx); const float inv = 1.0f / (((e0 + e1) + e2) + e3);
        const float p0 = e0 * inv, p1 = e1 * inv, p2 = e2 * inv, p3 = e3 * inv;
        LBV[c] = (p0 + p1) - p0; LBV[DM + c] = (((p0 + p1) + p2) + p3) - p0; }
}

__device__ __forceinline__ void swa_kprep(const Frame& F0, bf16* PROJ, const f32x2* ROPE, const float* knorm) {
    Frame F = fresh(F0);
    for (int idx = F.gtid; idx < M * 2; idx += F.NT) { const int tok = idx >> 1, kvh = idx & 1; bf16* kp = PROJ + (size_t)tok * AB_IN + 512 + kvh * 64;
        float f[64]; float ss = 0.f;
#pragma unroll
        for (int i = 0; i < 8; ++i) unpack8(((const v4u*)kp)[i], f + 8 * i);
#pragma unroll
        for (int d = 0; d < 64; ++d) ss += f[d] * f[d];
        const float r = 1.0f / sqrtf(ss * (1.0f / 64) + EPS);
#pragma unroll
        for (int d = 0; d < 64; ++d) f[d] *= r * knorm[d];
        const f32x2* tb = ROPE + (size_t)tok * 32;
#pragma unroll
        for (int i = 0; i < 32; ++i) { const f32x2 cs = tb[i]; const float a = f[i], b = f[i + 32]; f[i] = a * cs.x - b * cs.y; f[i + 32] = b * cs.x + a * cs.y; }
#pragma unroll
        for (int i = 0; i < 8; ++i) ((v4u*)kp)[i] = pack8(f + 8 * i); }
}
__device__ __forceinline__ void swa_naive(const Frame& F0, const bf16* PROJ, bf16* AO, const f32x2* ROPE, const float* qnorm, const float* sinks) {
    Frame F = fresh(F0);
    for (int task = F.gw; task < 8192; task += F.NGW) { const int blk = task & 31, hq = (task >> 5) & 7, b = task >> 8; const int T0 = blk * 64, t = T0 + F.lane, tok = b * SEQ + t;
        float q[64]; float ss = 0.f; const bf16* qp = PROJ + (size_t)tok * AB_IN + hq * 64;
#pragma unroll
        for (int i = 0; i < 8; ++i) unpack8(((const v4u*)qp)[i], q + 8 * i);
#pragma unroll
        for (int d = 0; d < 64; ++d) ss += q[d] * q[d];
        const float r = 0.125f / sqrtf(ss * (1.0f / 64) + EPS);
#pragma unroll
        for (int d = 0; d < 64; ++d) q[d] *= r * qnorm[d];
        const f32x2* tb = ROPE + (size_t)tok * 32;
#pragma unroll
        for (int i = 0; i < 32; ++i) { const f32x2 cs = tb[i]; const float a = q[i], bb = q[i + 32]; q[i] = a * cs.x - bb * cs.y; q[i + 32] = bb * cs.x + a * cs.y; }
        float m = sinks[hq], l = 1.f; float o[64];
#pragma unroll
        for (int d = 0; d < 64; ++d) o[d] = 0.f;
        const int kvh = hq >> 2; const int slo = (T0 - 127) > 0 ? (T0 - 127) : 0;
        for (int s = slo; s <= T0 + 63; ++s) { const bf16* kr = PROJ + (size_t)(b * SEQ + s) * AB_IN + 512 + kvh * 64; float sc = 0.f;
#pragma unroll
            for (int i = 0; i < 8; ++i) { float kf[8]; unpack8(((const v4u*)kr)[i], kf);
#pragma unroll
                for (int j = 0; j < 8; ++j) sc += q[8 * i + j] * kf[j]; }
            const bool valid = (s <= t) && (t - s < 128);
            const float mn = valid ? fmaxf(m, sc) : m; const float alpha = __expf(m - mn); const float p = valid ? __expf(sc - mn) : 0.f; l = l * alpha + p; m = mn;
#pragma unroll
            for (int i = 0; i < 8; ++i) { float vf[8]; unpack8(((const v4u*)(kr + 128))[i], vf);
#pragma unroll
                for (int j = 0; j < 8; ++j) o[8 * i + j] = o[8 * i + j] * alpha + p * vf[j]; } }
        const float inv = 1.0f / l; bf16* op = AO + (size_t)tok * DM + hq * 64;
#pragma unroll
        for (int d = 0; d < 64; ++d) o[d] *= inv;
#pragma unroll
        for (int i = 0; i < 8; ++i) ((v4u*)op)[i] = pack8(o + 8 * i); }
}
__device__ __forceinline__ void sb_naive(const Frame& F0, const bf16* PROJ, bf16* AO) {
    Frame F = fresh(F0);
    for (int task = F.gw; task < 8192; task += F.NGW) { const int rr = task >> 11, g = task & 2047; const int braw = g & 31, bh = rr * 64 + (g >> 5), blk = (rr & 1) ? 31 - braw : braw; const int b = bh >> 3, h = bh & 7;
        const int T0 = blk * 64, t = T0 + F.lane, tok = b * SEQ + t;
        float q[64]; const bf16* qp = PROJ + (size_t)tok * AB_IN + 768 + h * 64;
#pragma unroll
        for (int i = 0; i < 8; ++i) unpack8(((const v4u*)qp)[i], q + 8 * i);
#pragma unroll
        for (int d = 0; d < 64; ++d) q[d] *= 0.125f;
        float la = 0.f; float o[64];
#pragma unroll
        for (int d = 0; d < 64; ++d) o[d] = 0.f;
        for (int s = T0 + 62; s >= 0; --s) { const bf16* kr = PROJ + (size_t)(b * SEQ + s) * AB_IN + 1280 + h * 64; float z = 0.f;
#pragma unroll
            for (int i = 0; i < 8; ++i) { float kf[8]; unpack8(((const v4u*)kr)[i], kf);
#pragma unroll
                for (int j = 0; j < 8; ++j) z += q[8 * i + j] * kf[j]; }
            const bool valid = s < t;
            const float sp = fmaxf(z, 0.f) + log1pf(__expf(-fabsf(z)));
            const float a = valid ? __expf(z - sp + la) : 0.f; la -= valid ? sp : 0.f;
#pragma unroll
            for (int i = 0; i < 8; ++i) { float vf[8]; unpack8(((const v4u*)(kr + 512))[i], vf);
#pragma unroll
                for (int j = 0; j < 8; ++j) o[8 * i + j] += a * vf[j]; } }
        bf16* op = AO + (size_t)tok * DM + 512 + h * 64;
#pragma unroll
        for (int i = 0; i < 8; ++i) ((v4u*)op)[i] = pack8(o + 8 * i); }
}
__device__ __forceinline__ void hgrn_naive(const Frame& F0, const bf16* PROJ, bf16* AO, float* OSQ, const float* lbv) {
    Frame F = fresh(F0);
    if (F.wave < 2) { const int task = F.vcu * 2 + F.wave; if (task < 512) { const int b = task >> 4, h = (task >> 1) & 7, half = task & 1, e = half * 64 + F.lane;
        LAS float* sh = (LAS float*)(F.lds + F.wave * 2048); const LAS f32x4* sh4 = (const LAS f32x4*)sh;
        float S[128];
#pragma unroll
        for (int d = 0; d < 128; ++d) S[d] = 0.f;
        const float lb0 = lbv[h * 128 + F.lane], lb1 = lbv[h * 128 + 64 + F.lane];
        for (int t = 0; t < SEQ; ++t) { const size_t tok = (size_t)b * SEQ + t; const bf16* row = PROJ + tok * HG_IN + h * 128;
            const float q0 = bf2f(row[F.lane]), q1 = bf2f(row[64 + F.lane]), z0 = bf2f(row[1024 + F.lane]), z1 = bf2f(row[1024 + 64 + F.lane]), v = bf2f(row[2048 + e]);
            const float sg0 = 1.0f / (1.0f + __expf(-z0)), sg1 = 1.0f / (1.0f + __expf(-z1));
            sh[F.lane] = q0; sh[64 + F.lane] = q1; sh[128 + F.lane] = lb0 + (1.0f - lb0) * sg0; sh[192 + F.lane] = lb1 + (1.0f - lb1) * sg1;
            sh[256 + F.lane] = (1.0f - lb0) * (1.0f - sg0); sh[320 + F.lane] = (1.0f - lb1) * (1.0f - sg1);
            LDS_WAIT(); asm volatile("" ::: "memory");
            float o = 0.f;
#pragma unroll
            for (int d4 = 0; d4 < 32; ++d4) { const f32x4 qq = sh4[d4], ff = sh4[32 + d4], kk = sh4[64 + d4];
#pragma unroll
                for (int i = 0; i < 4; ++i) { S[4 * d4 + i] = ff[i] * S[4 * d4 + i] + kk[i] * v; o += qq[i] * S[4 * d4 + i]; } }
            LDS_WAIT(); asm volatile("" ::: "memory");
            AO[tok * DM + h * 128 + e] = (bf16)f2bf(o);
            const float ssum = wave_sum(o * o); if (F.lane == 0) OSQ[tok * 16 + h * 2 + half] = ssum; } } }
}
__device__ __forceinline__ void hgrn_post(const Frame& F0, const bf16* PROJ, bf16* AO, const float* OSQ, const float* onorm) {
    Frame F = fresh(F0);
    for (int idx = F.gtid; idx < M * 128; idx += F.NT) { const size_t tok = (size_t)(idx >> 7); const int col = (idx & 127) * 8, h = col >> 7;
        float o[8], g[8]; unpack8(*(const v4u*)(AO + tok * DM + col), o); unpack8(*(const v4u*)(PROJ + tok * HG_IN + 3072 + col), g);
        const float r = 1.0f / sqrtf((OSQ[tok * 16 + h * 2] + OSQ[tok * 16 + h * 2 + 1]) * (1.0f / 128) + EPS);
#pragma unroll
        for (int i = 0; i < 8; ++i) o[i] = o[i] * r * onorm[(col & 127) + i] * (g[i] / (1.0f + __expf(-g[i])));
        *(v4u*)(AO + tok * DM + col) = pack8(o); }
}
__device__ __forceinline__ void cross_naive(const Frame& F0, const bf16* Q, const bf16* KV, bf16* AO, const float* gq, const float* gk) {
    Frame F = fresh(F0);
    LAS float* P = (LAS float*)(F.lds + F.wave * 8192);
    for (int task = F.gw; task < 32768; task += F.NGW) { const int r0 = (task & 255) * 8, hd = (task >> 8) & 3, b = task >> 10;
        const bf16* qb = Q + (size_t)(b * SEQ + r0) * DM + hd * 256; const bf16* kb = KV + (size_t)(b * NMEM) * 2048 + hd * 256;
        float s[8][4], qss[8], kss[4];
#pragma unroll
        for (int r = 0; r < 8; ++r) { qss[r] = 0.f;
#pragma unroll
            for (int j = 0; j < 4; ++j) s[r][j] = 0.f; }
#pragma unroll
        for (int j = 0; j < 4; ++j) kss[j] = 0.f;
#pragma unroll 1
        for (int dc = 0; dc < 32; ++dc) { float G8[8], kf[4][8];
#pragma unroll
            for (int i = 0; i < 8; ++i) G8[i] = gq[dc * 8 + i] * gk[dc * 8 + i];
#pragma unroll
            for (int j = 0; j < 4; ++j) { unpack8(*(const v4u*)(kb + (size_t)(F.lane + 64 * j) * 2048 + dc * 8), kf[j]);
#pragma unroll
                for (int i = 0; i < 8; ++i) kss[j] += kf[j][i] * kf[j][i]; }
#pragma unroll
            for (int r = 0; r < 8; ++r) { float qf[8]; unpack8(*(const v4u*)(qb + (size_t)r * DM + dc * 8), qf);
#pragma unroll
                for (int i = 0; i < 8; ++i) { qss[r] += qf[i] * qf[i]; qf[i] *= G8[i]; }
#pragma unroll
                for (int j = 0; j < 4; ++j)
#pragma unroll
                    for (int i = 0; i < 8; ++i) s[r][j] += qf[i] * kf[j][i]; } }
        float rk[4];
#pragma unroll
        for (int j = 0; j < 4; ++j) rk[j] = 1.0f / sqrtf(kss[j] * (1.0f / 256) + EPS);
#pragma unroll
        for (int r = 0; r < 8; ++r) { const float rq = 0.0625f / sqrtf(qss[r] * (1.0f / 256) + EPS); float mx = -3.0e38f;
#pragma unroll
            for (int j = 0; j < 4; ++j) { s[r][j] *= rq * rk[j]; mx = fmaxf(mx, s[r][j]); }
            mx = wave_max(mx); float sum = 0.f;
#pragma unroll
            for (int j = 0; j < 4; ++j) { s[r][j] = __expf(s[r][j] - mx); sum += s[r][j]; }
            sum = wave_sum(sum); const float inv = 1.0f / sum;
#pragma unroll
            for (int j = 0; j < 4; ++j) P[r * 256 + F.lane + 64 * j] = s[r][j] * inv; }
        LDS_WAIT(); asm volatile("" ::: "memory");
        float o[8][4];
#pragma unroll
        for (int r = 0; r < 8; ++r)
#pragma unroll
            for (int i = 0; i < 4; ++i) o[r][i] = 0.f;
        const bf16* vb = KV + (size_t)(b * NMEM) * 2048 + 1024 + hd * 256 + F.lane * 4;
#pragma unroll 1
        for (int m4 = 0; m4 < 64; ++m4) {
            f32x4 pr[8];
#pragma unroll
            for (int r = 0; r < 8; ++r) pr[r] = *(const LAS f32x4*)(P + r * 256 + m4 * 4);
#pragma unroll
            for (int mm = 0; mm < 4; ++mm) { const v2u vw = *(const v2u*)(vb + (size_t)(m4 * 4 + mm) * 2048); const float v0 = bflo(vw.x), v1 = bfhi(vw.x), v2 = bflo(vw.y), v3 = bfhi(vw.y);
#pragma unroll
                for (int r = 0; r < 8; ++r) { const float p = pr[r][mm]; o[r][0] += p * v0; o[r][1] += p * v1; o[r][2] += p * v2; o[r][3] += p * v3; } } }
        LDS_WAIT(); asm volatile("" ::: "memory");
#pragma unroll
        for (int r = 0; r < 8; ++r) { v2u w; w.x = pk2(o[r][0], o[r][1]); w.y = pk2(o[r][2], o[r][3]); *(v2u*)(AO + (size_t)(b * SEQ + r0 + r) * DM + hd * 256 + F.lane * 4) = w; } }
}
__device__ __forceinline__ void conv_naive(const Frame& F0, const bf16* U, bf16* ACT, const float* cw, const float* cb) {
    Frame F = fresh(F0);
    for (int idx = F.gtid; idx < MH * 22 * 16; idx += F.NT) { const int c8 = idx & 15; const int rj = idx >> 4; const int j = rj % 22, row = rj / 22; const int t = row & (SEQ - 1); const int ch = j * 128 + c8 * 8;
        const bf16* up = U + (size_t)row * UPN + j * 256 + c8 * 8;
        float g0[8], u0[8], g1[8], u1[8], g2[8], u2[8];
        unpack8(*(const v4u*)up, g0); unpack8(*(const v4u*)(up + 128), u0);
        if (t >= 1) { unpack8(*(const v4u*)(up - UPN), g1); unpack8(*(const v4u*)(up - UPN + 128), u1); } else {
#pragma unroll
            for (int i = 0; i < 8; ++i) { g1[i] = 0.f; u1[i] = 0.f; } }
        if (t >= 2) { unpack8(*(const v4u*)(up - 2 * UPN), g2); unpack8(*(const v4u*)(up - 2 * UPN + 128), u2); } else {
#pragma unroll
            for (int i = 0; i < 8; ++i) { g2[i] = 0.f; u2[i] = 0.f; } }
        float o[8];
#pragma unroll
        for (int i = 0; i < 8; ++i) { const int cg = ch + i, cu = DFF + ch + i;
            const float gg = cw[2 * UPN + cg] * g0[i] + cw[UPN + cg] * g1[i] + cw[cg] * g2[i] + cb[cg];
            const float uu = cw[2 * UPN + cu] * u0[i] + cw[UPN + cu] * u1[i] + cw[cu] * u2[i] + cb[cu];
            o[i] = (gg / (1.0f + __expf(-gg))) * uu; }
        *(v4u*)(ACT + (size_t)row * DFF + ch) = pack8(o); }
}
__device__ __forceinline__ void ffn_fix(const Frame& F0, const float* EDGE, bf16* ACT, const float* cw, const float* cb) {
    Frame F = fresh(F0);
    for (int idx = F.gtid; idx < (M / 128) * 352; idx += F.NT) { const int strip = idx / 352, c8 = idx - strip * 352, ch = c8 * 8, colg = 256 * (ch >> 7) + (ch & 127); const bool hp = ((strip * 128) & (SEQ - 1)) != 0;
        const float* e0 = EDGE + (size_t)strip * 4 * UPN; const float* ep = e0 - (hp ? 4 * UPN : 0);
        float o0[8], o1[8];
#pragma unroll
        for (int hlf = 0; hlf < 2; ++hlf) {
            const int col = colg + 128 * hlf, wc0 = hlf * DFF + ch; float r0[8], r1[8], p2[8], p3[8], w0[8], w1[8], w2[8], bb[8];
#pragma unroll
            for (int q = 0; q < 2; ++q) { const f32x4 a = *(const f32x4*)(e0 + col + 4 * q), b = *(const f32x4*)(e0 + UPN + col + 4 * q), c = *(const f32x4*)(ep + 2 * UPN + col + 4 * q), d = *(const f32x4*)(ep + 3 * UPN + col + 4 * q);
                const f32x4 x0 = *(const f32x4*)(cw + wc0 + 4 * q), x1 = *(const f32x4*)(cw + UPN + wc0 + 4 * q), x2 = *(const f32x4*)(cw + 2 * UPN + wc0 + 4 * q), xb = *(const f32x4*)(cb + wc0 + 4 * q);
#pragma unroll
                for (int i = 0; i < 4; ++i) { r0[4 * q + i] = a[i]; r1[4 * q + i] = b[i]; p2[4 * q + i] = hp ? c[i] : 0.f; p3[4 * q + i] = hp ? d[i] : 0.f; w0[4 * q + i] = x0[i]; w1[4 * q + i] = x1[i]; w2[4 * q + i] = x2[i]; bb[4 * q + i] = xb[i]; } }
#pragma unroll
            for (int i = 0; i < 8; ++i) { const float y0 = w2[i] * r0[i] + w1[i] * p3[i] + w0[i] * p2[i] + bb[i], y1 = w2[i] * r1[i] + w1[i] * r0[i] + w0[i] * p3[i] + bb[i];
                if (hlf == 0) { o0[i] = y0 / (1.0f + __expf(-y0)); o1[i] = y1 / (1.0f + __expf(-y1)); } else { o0[i] *= y0; o1[i] *= y1; } } }
        *(v4u*)(ACT + (size_t)(strip * 128) * DFF + ch) = pack8(o0); *(v4u*)(ACT + (size_t)(strip * 128 + 1) * DFF + ch) = pack8(o1); }
}
typedef short bf16x8 __attribute__((ext_vector_type(8)));
typedef unsigned u32x4s __attribute__((ext_vector_type(4)));
typedef short s16x4 __attribute__((ext_vector_type(4)));
typedef short v4i16_t __attribute__((ext_vector_type(4)));
typedef float f32x16 __attribute__((ext_vector_type(16)));
constexpr float LOG2E = 1.4426950408889634f;
__device__ __forceinline__ int img_off(int row, int ch, int c16) { return (row >> 3) * c16 + 512 * (ch >> 2) + 64 * (row & 7) + 16 * ((ch & 3) ^ ((row >> 2) & 3)); }
struct ImgLane { int rd0, rd1, tr0, tr1, wr; };
__device__ __forceinline__ ImgLane img_lane(int lane, int tid) { ImgLane L; const int r32 = lane & 31, h = lane >> 5, blk = (lane >> 4) & 1, q = (lane & 15) >> 2, p = lane & 3;
    L.rd0 = (r32 >> 3) * 1024 + 64 * (r32 & 7) + 16 * (h ^ ((r32 >> 2) & 3)); L.rd1 = L.rd0 ^ 32;
    L.tr0 = 64 * (4 * h + q) + 16 * ((2 * blk + (p >> 1)) ^ h) + 8 * (p & 1); L.tr1 = L.tr0 ^ 32;
    L.wr = img_off(tid >> 3, tid & 7, 1024); return L; }
#define IMG_ROW_READ(img, L, rb, s) (*(const LAS bf16x8*)((img) + (((s) & 1) ? (L).rd1 : (L).rd0) + 4096 * (rb) + 512 * ((s) >> 1)))
__device__ __forceinline__ s16x4 tr_rd(const LAS unsigned char* p) { return __builtin_bit_cast(s16x4, __builtin_amdgcn_ds_read_tr16_b64_v4i16((LAS v4i16_t*)p)); }
#define IMG_TR_FRAG_ACC(dst, img, L, k0, c) do { const s16x4 lo_ = tr_rd((img) + (L).tr0 + ((k0) >> 3) * 1024 + 512 * (c)), hi_ = tr_rd((img) + (L).tr1 + (((k0) >> 3) + 1) * 1024 + 512 * (c)); \
    dst = (bf16x8){lo_[0], lo_[1], lo_[2], lo_[3], hi_[0], hi_[1], hi_[2], hi_[3]}; } while (0)
__device__ __forceinline__ unsigned cvtpk(float lo, float hi) { unsigned r; asm("s_nop 0\n\tv_cvt_pk_bf16_f32 %0, %1, %2" : "=v"(r) : "v"(lo), "v"(hi)); return r; }
__device__ __forceinline__ bf16x8 pack_acc(const f32x16& a, int s) { v4u w; w.x = cvtpk(a[8 * s + 0], a[8 * s + 1]); w.y = cvtpk(a[8 * s + 2], a[8 * s + 3]); w.z = cvtpk(a[8 * s + 4], a[8 * s + 5]); w.w = cvtpk(a[8 * s + 6], a[8 * s + 7]);
    asm volatile("s_nop 1" : "+v"(w));
    return __builtin_bit_cast(bf16x8, w); }
__device__ __forceinline__ float sumsq8(const v4u w) { float f[8]; unpack8(w, f); return ((f[0] * f[0] + f[1] * f[1]) + (f[2] * f[2] + f[3] * f[3])) + ((f[4] * f[4] + f[5] * f[5]) + (f[6] * f[6] + f[7] * f[7])); }
#define MFMA32(a, b, c) __builtin_amdgcn_mfma_f32_32x32x16_bf16((a), (b), (c), 0, 0, 0)
#define WG_BAR() do { asm volatile("s_waitcnt vmcnt(0) lgkmcnt(0)" ::: "memory"); __builtin_amdgcn_s_barrier(); asm volatile("" ::: "memory"); } while (0)
#define WG_BAR_LDS() do { asm volatile("s_waitcnt lgkmcnt(0)" ::: "memory"); __builtin_amdgcn_s_barrier(); asm volatile("" ::: "memory"); } while (0)

__device__ __forceinline__ void cross_mfma(const Frame& F0, const bf16* Q, const bf16* KV, bf16* AO, const float* gq, const float* gk) {
    Frame F = fresh(F0);
    LAS unsigned char* const buf0 = F.lds; LAS unsigned char* const buf1 = F.lds + 65536;
    float M0; { float g = 0.f;
#pragma unroll
        for (int j = 0; j < 4; ++j) g = fmaxf(g, fabsf(gq[F.lane + 64 * j] * gk[F.lane + 64 * j]));
        M0 = __uint_as_float(__builtin_amdgcn_readfirstlane(__float_as_uint(wave_max(g) * (16.0f * LOG2E)))); }
    for (int unit = F.vcu; unit < 1024; unit += F.G) { const int qb = unit & 7, hd = (unit >> 3) & 3, b = unit >> 5;
        int tid2 = threadIdx.x; asm volatile("" : "+v"(tid2));
        const int lane = tid2 & 63, w = F.wave, r32 = lane & 31, h = lane >> 5, prow = tid2 >> 3, pch = tid2 & 7;
        const ImgLane L = img_lane(lane, tid2);
        const int prow2 = prow;
        const bf16* kbase = KV + (size_t)(b * NMEM) * 2048 + hd * 256 + (size_t)prow2 * 2048 + 8 * pch; const bf16* vbase = kbase + 1024;
        const size_t tok = (size_t)b * SEQ + qb * 256 + w * 32 + r32;
        const bf16* qrow = Q + tok * DM + hd * 256 + 8 * h;
        v4u qn[4]; float qss = 0.f, rq = 0.f, l = 0.f;
#pragma unroll
        for (int s = 0; s < 4; ++s) qn[s] = *(const v4u*)(qrow + 16 * s);
        f32x16 acc[4];
#pragma unroll
        for (int kb = 0; kb < 4; ++kb)
#pragma unroll
            for (int i = 0; i < 16; ++i) acc[kb][i] = 0.f;
        bf16x8 pf[8][2];
        v4u pre[8];
#define XK_LOAD(KH_) do { _Pragma("unroll") for (int c = 0; c < 4; ++c) _Pragma("unroll") for (int i = 0; i < 2; ++i) pre[2 * c + i] = *(const v4u*)(kbase + (size_t)(128 * (KH_) + 64 * i) * 2048 + 64 * c); } while (0)
#define XV_LOAD(VH_) do { _Pragma("unroll") for (int j = 0; j < 2; ++j) _Pragma("unroll") for (int i = 0; i < 4; ++i) pre[4 * j + i] = *(const v4u*)(vbase + (size_t)(64 * i) * 2048 + 64 * (2 * (VH_) + j)); } while (0)
        XK_LOAD(0);
        float linv = 0.f;
#pragma unroll
        for (int kh = 0; kh < 2; ++kh) { LAS unsigned char* const buf = kh ? buf1 : buf0;
#pragma unroll
            for (int c = 0; c < 4; ++c)
#pragma unroll
                for (int i = 0; i < 2; ++i) *(LAS v4u*)(buf + 16384 * c + L.wr + 8192 * i) = pre[2 * c + i];
            WG_BAR_LDS();
            if (kh == 0) XK_LOAD(1); else XV_LOAD(0);
#pragma unroll
            for (int dc = 0; dc < 4; ++dc) {
                bf16x8 qf[4];
#pragma unroll
                for (int s = 0; s < 4; ++s) { if (kh == 0) qss += sumsq8(qn[s]); qf[s] = __builtin_bit_cast(bf16x8, qn[s]); }
                if (!(kh == 1 && dc == 3)) {
#pragma unroll
                    for (int s = 0; s < 4; ++s) qn[s] = *(const v4u*)(qrow + 64 * ((dc + 1) & 3) + 16 * s); }
                if (kh == 0 && dc == 3) { qss += __shfl_xor(qss, 32); rq = (0.0625f * LOG2E) / sqrtf(qss * (1.0f / 256) + EPS); }
#pragma unroll
                for (int kb = 0; kb < 4; ++kb) { __builtin_amdgcn_s_setprio(1);
#pragma unroll
                    for (int s = 0; s < 4; ++s) acc[kb] = MFMA32(IMG_ROW_READ(buf + 16384 * dc, L, kb, s), qf[s], acc[kb]);
                    __builtin_amdgcn_s_setprio(0); asm volatile("" ::: "memory"); }
                __builtin_amdgcn_sched_barrier(0); }
#pragma unroll
            for (int kb = 0; kb < 4; ++kb) { asm volatile("" : "+v"(acc[kb]) :: "memory");
#pragma unroll
                for (int i = 0; i < 16; ++i) { const float p = __builtin_amdgcn_exp2f(__builtin_fmaf(acc[kb][i], rq, -M0)); acc[kb][i] = p; l += p; }
                pf[kh * 4 + kb][0] = pack_acc(acc[kb], 0); pf[kh * 4 + kb][1] = pack_acc(acc[kb], 1);
#pragma unroll
                for (int i = 0; i < 16; ++i) acc[kb][i] = 0.f; }
            __builtin_amdgcn_sched_barrier(0);
        }
        l += __shfl_xor(l, 32); linv = 1.0f / l;
#pragma unroll
        for (int vh = 0; vh < 2; ++vh) { LAS unsigned char* const buf = vh ? buf1 : buf0;
#pragma unroll
            for (int j = 0; j < 2; ++j)
#pragma unroll
                for (int i = 0; i < 4; ++i) *(LAS v4u*)(buf + 32768 * j + L.wr + 8192 * i) = pre[4 * j + i];
            WG_BAR_LDS();
            if (vh == 0) XV_LOAD(1);
#pragma unroll
            for (int j = 0; j < 2; ++j) { const int vc = 2 * vh + j;
                f32x16 o[2];
#pragma unroll
                for (int c = 0; c < 2; ++c) {
#pragma unroll
                    for (int i = 0; i < 16; ++i) o[c][i] = 0.f;
#pragma unroll
                    for (int kb = 0; kb < 8; ++kb) { __builtin_amdgcn_s_setprio(1);
#pragma unroll
                        for (int s = 0; s < 2; ++s) { bf16x8 vf; IMG_TR_FRAG_ACC(vf, buf + 32768 * j, L, 32 * kb + 16 * s, c); o[c] = MFMA32(vf, pf[kb][s], o[c]); }
                        __builtin_amdgcn_s_setprio(0); asm volatile("" ::: "memory"); } }
                bf16* op = AO + tok * DM + hd * 256 + 64 * vc + 4 * h;
#pragma unroll
                for (int c = 0; c < 2; ++c)
#pragma unroll
                    for (int g = 0; g < 4; ++g) { v2u wv; wv.x = cvtpk(o[c][4 * g] * linv, o[c][4 * g + 1] * linv); wv.y = cvtpk(o[c][4 * g + 2] * linv, o[c][4 * g + 3] * linv); *(v2u*)(op + 32 * c + 8 * g) = wv; }
                __builtin_amdgcn_sched_barrier(0); }
        }
#undef XK_LOAD
#undef XV_LOAD
    }
    WG_BAR();
}
constexpr float SB_ZSCALE = 0.125f * LOG2E;
template <bool MASKED>
__device__ __forceinline__ void sb_block(const LAS unsigned char* kimg, const LAS unsigned char* vimg, const ImgLane& L, const int kb, const bf16x8 (&qf)[4], f32x16 (&o)[2], float& K, const int key0, const int t, const int h) {
    f32x16 z;
#pragma unroll
    for (int i = 0; i < 16; ++i) z[i] = 0.f;
#pragma unroll
    for (int s = 0; s < 4; ++s) z = MFMA32(IMG_ROW_READ(kimg, L, kb, s), qf[s], z);
    float R[16];
#pragma unroll
    for (int r = 0; r < 16; ++r) { float E = __builtin_amdgcn_exp2f(z[r] * SB_ZSCALE);
        if (MASKED) { const int key = key0 + (r & 3) + 8 * (r >> 2) + 4 * h; E = (key < t) ? E : 0.f; }
        R[r] = __builtin_amdgcn_rcpf(1.0f + E); }
    float G[4], Gp[4], T[4];
#pragma unroll
    for (int g = 0; g < 4; ++g) { G[g] = (R[4 * g] * R[4 * g + 1]) * (R[4 * g + 2] * R[4 * g + 3]); Gp[g] = __shfl_xor(G[g], 32); T[g] = G[g] * Gp[g]; }
    float after[4]; after[3] = K; after[2] = K * T[3]; after[1] = after[2] * T[2]; after[0] = after[1] * T[1];
#pragma unroll
    for (int g = 0; g < 4; ++g) { const float S3 = after[g] * (h == 0 ? Gp[g] : 1.0f), S2 = S3 * R[4 * g + 3], S1 = S2 * R[4 * g + 2], S0 = S1 * R[4 * g + 1], Sm = S0 * R[4 * g];
        z[4 * g + 3] = S3 - S2; z[4 * g + 2] = S2 - S1; z[4 * g + 1] = S1 - S0; z[4 * g + 0] = S0 - Sm; }
    K = after[0] * T[0];
    const bf16x8 p0 = pack_acc(z, 0), p1 = pack_acc(z, 1);
#pragma unroll
    for (int c = 0; c < 2; ++c) { bf16x8 vf; IMG_TR_FRAG_ACC(vf, vimg, L, 32 * kb, c); o[c] = MFMA32(vf, p0, o[c]); IMG_TR_FRAG_ACC(vf, vimg, L, 32 * kb + 16, c); o[c] = MFMA32(vf, p1, o[c]); }
}
__device__ __forceinline__ void sb_tile2(const LAS unsigned char* kimg, const LAS unsigned char* vimg, const ImgLane& L, const bf16x8 (&qf)[4], f32x16 (&o)[2], float& K, const int h) {
    f32x16 z[2];
#pragma unroll
    for (int b = 0; b < 2; ++b)
#pragma unroll
        for (int i = 0; i < 16; ++i) z[b][i] = 0.f;
#pragma unroll
    for (int s = 0; s < 4; ++s) z[1] = MFMA32(IMG_ROW_READ(kimg, L, 1, s), qf[s], z[1]);
#pragma unroll
    for (int s = 3; s >= 0; --s) z[0] = MFMA32(IMG_ROW_READ(kimg, L, 0, s), qf[s], z[0]);
    float R[2][16];
#pragma unroll
    for (int b = 0; b < 2; ++b)
#pragma unroll
        for (int r = 0; r < 16; ++r) { const float E = __builtin_amdgcn_exp2f(z[b][r] * SB_ZSCALE); R[b][r] = __builtin_amdgcn_rcpf(1.0f + E); }
    float G[2][4], Gp[2][4], T[2][4];
#pragma unroll
    for (int b = 0; b < 2; ++b)
#pragma unroll
        for (int g = 0; g < 4; ++g) G[b][g] = (R[b][4 * g] * R[b][4 * g + 1]) * (R[b][4 * g + 2] * R[b][4 * g + 3]);
#pragma unroll
    for (int b = 0; b < 2; ++b)
#pragma unroll
        for (int g = 0; g < 4; ++g) Gp[b][g] = __shfl_xor(G[b][g], 32);
#pragma unroll
    for (int b = 0; b < 2; ++b)
#pragma unroll
        for (int g = 0; g < 4; ++g) T[b][g] = G[b][g] * Gp[b][g];
    const float K1 = K, K0 = K * ((T[1][0] * T[1][1]) * (T[1][2] * T[1][3]));
#pragma unroll
    for (int b = 0; b < 2; ++b) { float after[4]; after[3] = b ? K1 : K0; after[2] = after[3] * T[b][3]; after[1] = after[2] * T[b][2]; after[0] = after[1] * T[b][1];
#pragma unroll
        for (int g = 0; g < 4; ++g) { const float S3 = after[g] * (h == 0 ? Gp[b][g] : 1.0f), S2 = S3 * R[b][4 * g + 3], S1 = S2 * R[b][4 * g + 2], S0 = S1 * R[b][4 * g + 1], Sm = S0 * R[b][4 * g];
            z[b][4 * g + 3] = S3 - S2; z[b][4 * g + 2] = S2 - S1; z[b][4 * g + 1] = S1 - S0; z[b][4 * g + 0] = S0 - Sm; }
        if (b == 0) K = after[0] * T[0][0]; }
    const bf16x8 p10 = pack_acc(z[1], 0), p11 = pack_acc(z[1], 1), p00 = pack_acc(z[0], 0), p01 = pack_acc(z[0], 1);
#pragma unroll
    for (int c = 0; c < 2; ++c) { bf16x8 vf; IMG_TR_FRAG_ACC(vf, vimg, L, 32, c); o[c] = MFMA32(vf, p10, o[c]); IMG_TR_FRAG_ACC(vf, vimg, L, 48, c); o[c] = MFMA32(vf, p11, o[c]);
        IMG_TR_FRAG_ACC(vf, vimg, L, 0, c); o[c] = MFMA32(vf, p00, o[c]); IMG_TR_FRAG_ACC(vf, vimg, L, 16, c); o[c] = MFMA32(vf, p01, o[c]); }
}
#ifndef SB_EXIT_BITS
#define SB_EXIT_BITS 0x00008000u
#endif
__device__ __forceinline__ void sb_mfma(const Frame& F0, const bf16* PROJ, const bf16* HM, bf16* AO) {
    Frame F = fresh(F0);
    const int lane = F.lane, w = F.wave, r32 = lane & 31, h = lane >> 5;
    const ImgLane L = img_lane(lane, F.tid);
    LAS unsigned* const done = (LAS unsigned*)(F.lds + 131072 + 1024);
    if (lane < 2) done[lane * 8 + w] = 0u;
    WG_BAR_LDS();
    unsigned tag = 0u; int fi = 0;
    for (int bh = F.vcu; bh < 256; bh += F.G) { const int b = bh >> 3, hh = bh & 7;
        const bf16* kvb = HM + ((size_t)bh * SEQ + (F.tid >> 3)) * 64 + 8 * (F.tid & 7);
        constexpr size_t VOFF = (size_t)M * 512;
        v4u pk[4], pv[4];
#define SB_LOAD(T_) do { _Pragma("unroll") for (int i = 0; i < 4; ++i) { pk[i] = *(const v4u*)(kvb + (size_t)(256 * (T_) + 64 * i) * 64); pv[i] = *(const v4u*)(kvb + (size_t)(256 * (T_) + 64 * i) * 64 + VOFF); } } while (0)
#define SB_STORE(buf_) do { _Pragma("unroll") for (int i = 0; i < 4; ++i) { *(LAS v4u*)((buf_) + L.wr + 8192 * i) = pk[i]; *(LAS v4u*)((buf_) + 32768 + L.wr + 8192 * i) = pv[i]; } } while (0)
#define SB_WZ() (__all(__float_as_uint(carry) < SB_EXIT_BITS) != 0)
#define SB_ALLDONE(res_) do { const u32x4s d0_ = *(const LAS u32x4s*)(done + (fi & 1) * 8), d1_ = *(const LAS u32x4s*)(done + (fi & 1) * 8 + 4); \
            const unsigned mn_ = min(min(min(d0_.x, d0_.y), min(d0_.z, d0_.w)), min(min(d1_.x, d1_.y), min(d1_.z, d1_.w))); res_ = (unsigned)__builtin_amdgcn_readfirstlane(mn_) >= tag; ++fi; } while (0)
        SB_LOAD(0);
#pragma unroll 1
        for (int qb = 0; qb < 8; ++qb) { const int q0 = 256 * qb + 32 * w, t = q0 + r32; const size_t tok = (size_t)b * SEQ + t;
            bf16x8 qf[4];
#pragma unroll
            for (int s = 0; s < 4; ++s) qf[s] = __builtin_bit_cast(bf16x8, *(const v4u*)(PROJ + tok * AB_IN + 768 + hh * 64 + 16 * s + 8 * h));
            __builtin_amdgcn_s_waitcnt(0x0F70);
            f32x16 o[2];
#pragma unroll
            for (int c = 0; c < 2; ++c)
#pragma unroll
                for (int i = 0; i < 16; ++i) o[c][i] = 0.f;
            float carry = 1.f;
            ++tag; bool wz = false;
            LAS unsigned char* const own = F.lds + (qb & 1) * 65536; LAS unsigned char* const prev = F.lds + ((qb & 1) ^ 1) * 65536;
            SB_STORE(own);
            WG_BAR_LDS();
            if (qb < 7) SB_LOAD(qb + 1);
            { const int hb = w >> 1, j = 4 * qb + hb; const LAS unsigned char* const kimg = own + 8192 * hb; const LAS unsigned char* const vimg = own + 32768 + 8192 * hb;
              if (64 * j + 32 < q0 + 31) sb_block<true>(kimg, vimg, L, 1, qf, o, carry, 64 * j + 32, t, h);
              if (64 * j + 31 < q0) sb_block<false>(kimg, vimg, L, 0, qf, o, carry, 64 * j, t, h); else sb_block<true>(kimg, vimg, L, 0, qf, o, carry, 64 * j, t, h); }
            { const int n = (w >> 1) + (qb > 0 ? 4 : 0);
#pragma unroll 1
              for (int i = 0; i < n; ++i) { if (wz) break; const int hb = (w >> 1) - 1 - i; const LAS unsigned char* const base = (hb >= 0) ? own + 8192 * hb : prev + 8192 * (hb + 4);
                  sb_tile2(base, base + 32768, L, qf, o, carry, h); wz = SB_WZ(); } }
            if (wz && lane == 0) done[(fi & 1) * 8 + w] = tag;
            WG_BAR_LDS();
            if (qb >= 2) { bool alld; SB_ALLDONE(alld);
                if (!alld) {
#pragma unroll 1
                    for (int T = qb - 2; T >= 0; --T) { SB_LOAD(T); SB_STORE(prev); WG_BAR_LDS();
#pragma unroll 1
                        for (int hb = 3; hb >= 0; --hb) { if (wz) break; sb_tile2(prev + 8192 * hb, prev + 32768 + 8192 * hb, L, qf, o, carry, h); wz = SB_WZ(); }
                        if (wz && lane == 0) done[(fi & 1) * 8 + w] = tag;
                        WG_BAR_LDS();
                        SB_ALLDONE(alld); if (alld) break; }
                    if (qb < 7) SB_LOAD(qb + 1); } }
            bf16* op = AO + tok * DM + 512 + hh * 64 + 4 * h;
#pragma unroll
            for (int c = 0; c < 2; ++c)
#pragma unroll
                for (int g = 0; g < 4; ++g) { v2u wv; wv.x = cvtpk(o[c][4 * g], o[c][4 * g + 1]); wv.y = cvtpk(o[c][4 * g + 2], o[c][4 * g + 3]); *(v2u*)(op + 32 * c + 8 * g) = wv; }
        }
#undef SB_LOAD
#undef SB_STORE
#undef SB_WZ
#undef SB_ALLDONE
    }
    WG_BAR();
}
struct ImgLaneW { int rd0, rd1, tr0, tr1, n0, n1, qp; };
__device__ __forceinline__ ImgLaneW img_lane_w(int lane) { ImgLaneW L; const int r32 = lane & 31, h = lane >> 5, blk = (lane >> 4) & 1, q = (lane & 15) >> 2, p = lane & 3, x = (r32 >> 2) & 3;
    L.rd0 = (r32 >> 3) * 2048 + 64 * (r32 & 7) + 16 * (h ^ x); L.rd1 = L.rd0 ^ 32;
    L.tr0 = 64 * (4 * h + q) + 16 * ((2 * blk + (p >> 1)) ^ h) + 8 * (p & 1); L.tr1 = L.tr0 ^ 32;
    L.n0 = h * 2048 + 64 * q + 16 * ((2 * blk + (p >> 1)) ^ (2 * h)) + 8 * (p & 1); L.n1 = (L.n0 ^ 16) + 256;
    L.qp = (r32 >> 3) * 2048 + 64 * (r32 & 7) + 16 * x + 8 * h; return L; }
#define IMGW_ROW_READ(img, L, s) (*(const LAS bf16x8*)((img) + (((s) & 1) ? (L).rd1 : (L).rd0) + 512 * ((s) >> 1)))
#define IMGW_TR_FRAG_ACC(dst, img, L, k0, c) do { const s16x4 lo_ = tr_rd((img) + (L).tr0 + ((k0) >> 3) * 2048 + 512 * (c)), hi_ = tr_rd((img) + (L).tr1 + (((k0) >> 3) + 1) * 2048 + 512 * (c)); \
    dst = (bf16x8){lo_[0], lo_[1], lo_[2], lo_[3], hi_[0], hi_[1], hi_[2], hi_[3]}; } while (0)
#define IMGW_TR_FRAG_NAT(dst, img, L, k0, c) do { const s16x4 lo_ = tr_rd((img) + (L).n0 + ((k0) >> 3) * 2048 + 512 * (c)), hi_ = tr_rd((img) + (L).n1 + ((k0) >> 3) * 2048 + 512 * (c)); \
    dst = (bf16x8){lo_[0], lo_[1], lo_[2], lo_[3], hi_[0], hi_[1], hi_[2], hi_[3]}; } while (0)
#define IMGW_ROW_FRAG_ACC(dst, img, L, db, ks) do { const v2u lo_ = *(const LAS v2u*)((img) + ((L).qp ^ (32 * (ks))) + 512 * (db)), hi_ = *(const LAS v2u*)((img) + ((L).qp ^ (32 * (ks) + 16)) + 512 * (db)); \
    dst = __builtin_bit_cast(bf16x8, (v4u){lo_.x, lo_.y, hi_.x, hi_.y}); } while (0)
__device__ __forceinline__ float scan32(float x) {
    asm volatile("s_nop 4\n\tv_add_f32_dpp %0, %0, %0 row_shr:1 row_mask:0xf bank_mask:0xf bound_ctrl:1" : "+v"(x));
    asm volatile("s_nop 1\n\tv_add_f32_dpp %0, %0, %0 row_shr:2 row_mask:0xf bank_mask:0xf bound_ctrl:1" : "+v"(x));
    asm volatile("s_nop 1\n\tv_add_f32_dpp %0, %0, %0 row_shr:4 row_mask:0xf bank_mask:0xf bound_ctrl:1" : "+v"(x));
    asm volatile("s_nop 1\n\tv_add_f32_dpp %0, %0, %0 row_shr:8 row_mask:0xf bank_mask:0xf bound_ctrl:1" : "+v"(x));
    asm volatile("s_nop 1\n\tv_add_f32_dpp %0, %0, %0 row_bcast:15 row_mask:0xa bank_mask:0xf" : "+v"(x));
    return x; }
__device__ __forceinline__ void scan32x8(float (&x)[8]) {
    asm volatile(
        "s_nop 4\n\t"
        "v_add_f32_dpp %0, %0, %0 row_shr:1 row_mask:0xf bank_mask:0xf bound_ctrl:1\n\tv_add_f32_dpp %1, %1, %1 row_shr:1 row_mask:0xf bank_mask:0xf bound_ctrl:1\n\tv_add_f32_dpp %2, %2, %2 row_shr:1 row_mask:0xf bank_mask:0xf bound_ctrl:1\n\tv_add_f32_dpp %3, %3, %3 row_shr:1 row_mask:0xf bank_mask:0xf bound_ctrl:1\n\tv_add_f32_dpp %4, %4, %4 row_shr:1 row_mask:0xf bank_mask:0xf bound_ctrl:1\n\tv_add_f32_dpp %5, %5, %5 row_shr:1 row_mask:0xf bank_mask:0xf bound_ctrl:1\n\tv_add_f32_dpp %6, %6, %6 row_shr:1 row_mask:0xf bank_mask:0xf bound_ctrl:1\n\tv_add_f32_dpp %7, %7, %7 row_shr:1 row_mask:0xf bank_mask:0xf bound_ctrl:1\n\t"
        "v_add_f32_dpp %0, %0, %0 row_shr:2 row_mask:0xf bank_mask:0xf bound_ctrl:1\n\tv_add_f32_dpp %1, %1, %1 row_shr:2 row_mask:0xf bank_mask:0xf bound_ctrl:1\n\tv_add_f32_dpp %2, %2, %2 row_shr:2 row_mask:0xf bank_mask:0xf bound_ctrl:1\n\tv_add_f32_dpp %3, %3, %3 row_shr:2 row_mask:0xf bank_mask:0xf bound_ctrl:1\n\tv_add_f32_dpp %4, %4, %4 row_shr:2 row_mask:0xf bank_mask:0xf bound_ctrl:1\n\tv_add_f32_dpp %5, %5, %5 row_shr:2 row_mask:0xf bank_mask:0xf bound_ctrl:1\n\tv_add_f32_dpp %6, %6, %6 row_shr:2 row_mask:0xf bank_mask:0xf bound_ctrl:1\n\tv_add_f32_dpp %7, %7, %7 row_shr:2 row_mask:0xf bank_mask:0xf bound_ctrl:1\n\t"
        "v_add_f32_dpp %0, %0, %0 row_shr:4 row_mask:0xf bank_mask:0xf bound_ctrl:1\n\tv_add_f32_dpp %1, %1, %1 row_shr:4 row_mask:0xf bank_mask:0xf bound_ctrl:1\n\tv_add_f32_dpp %2, %2, %2 row_shr:4 row_mask:0xf bank_mask:0xf bound_ctrl:1\n\tv_add_f32_dpp %3, %3, %3 row_shr:4 row_mask:0xf bank_mask:0xf bound_ctrl:1\n\tv_add_f32_dpp %4, %4, %4 row_shr:4 row_mask:0xf bank_mask:0xf bound_ctrl:1\n\tv_add_f32_dpp %5, %5, %5 row_shr:4 row_mask:0xf bank_mask:0xf bound_ctrl:1\n\tv_add_f32_dpp %6, %6, %6 row_shr:4 row_mask:0xf bank_mask:0xf bound_ctrl:1\n\tv_add_f32_dpp %7, %7, %7 row_shr:4 row_mask:0xf bank_mask:0xf bound_ctrl:1\n\t"
        "v_add_f32_dpp %0, %0, %0 row_shr:8 row_mask:0xf bank_mask:0xf bound_ctrl:1\n\tv_add_f32_dpp %1, %1, %1 row_shr:8 row_mask:0xf bank_mask:0xf bound_ctrl:1\n\tv_add_f32_dpp %2, %2, %2 row_shr:8 row_mask:0xf bank_mask:0xf bound_ctrl:1\n\tv_add_f32_dpp %3, %3, %3 row_shr:8 row_mask:0xf bank_mask:0xf bound_ctrl:1\n\tv_add_f32_dpp %4, %4, %4 row_shr:8 row_mask:0xf bank_mask:0xf bound_ctrl:1\n\tv_add_f32_dpp %5, %5, %5 row_shr:8 row_mask:0xf bank_mask:0xf bound_ctrl:1\n\tv_add_f32_dpp %6, %6, %6 row_shr:8 row_mask:0xf bank_mask:0xf bound_ctrl:1\n\tv_add_f32_dpp %7, %7, %7 row_shr:8 row_mask:0xf bank_mask:0xf bound_ctrl:1\n\t"
        "v_add_f32_dpp %0, %0, %0 row_bcast:15 row_mask:0xa bank_mask:0xf\n\tv_add_f32_dpp %1, %1, %1 row_bcast:15 row_mask:0xa bank_mask:0xf\n\tv_add_f32_dpp %2, %2, %2 row_bcast:15 row_mask:0xa bank_mask:0xf\n\tv_add_f32_dpp %3, %3, %3 row_bcast:15 row_mask:0xa bank_mask:0xf\n\tv_add_f32_dpp %4, %4, %4 row_bcast:15 row_mask:0xa bank_mask:0xf\n\tv_add_f32_dpp %5, %5, %5 row_bcast:15 row_mask:0xa bank_mask:0xf\n\tv_add_f32_dpp %6, %6, %6 row_bcast:15 row_mask:0xa bank_mask:0xf\n\tv_add_f32_dpp %7, %7, %7 row_bcast:15 row_mask:0xa bank_mask:0xf\n\t"
        : "+v"(x[0]), "+v"(x[1]), "+v"(x[2]), "+v"(x[3]), "+v"(x[4]), "+v"(x[5]), "+v"(x[6]), "+v"(x[7]));
}
__device__ __forceinline__ float lane_of_half(float x, int l, int h) {
    const float a = __uint_as_float(__builtin_amdgcn_readlane(__float_as_uint(x), l)), b = __uint_as_float(__builtin_amdgcn_readlane(__float_as_uint(x), 32 + l)); return h ? b : a; }
constexpr int HG_QI = 0, HG_KI = 8192, HG_VI = 16384, HG_DEC = 24576, HG_OP = 26624, HG_OPS = 132;
__device__ __forceinline__ void hgrn_mfma(const Frame& F0, const bf16* PROJ, bf16* AO, const float* lbv, const float* onorm) {
    Frame F = fresh(F0);
    const int lane = F.lane, w = F.wave, r32 = lane & 31, h = lane >> 5, es = w & 3, dh = w >> 2;
    const ImgLaneW L = img_lane_w(lane);
    const int pt = lane & 31, dg = 2 * w + (lane >> 5), d0 = dg * 8, et = F.tid >> 4, eg = F.tid & 15;
    LAS unsigned char* const QI = F.lds + HG_QI; LAS unsigned char* const KI = F.lds + HG_KI; LAS unsigned char* const VI = F.lds + HG_VI;
    LAS unsigned char* const QB = F.lds + 61440;
    LAS float* const DEC = (LAS float*)(F.lds + HG_DEC); LAS float* const OP = (LAS float*)(F.lds + HG_OP);
    const int wr = img_off(pt, dg, 2048);
    for (int bh = F.vcu; bh < 256; bh += F.G) { const int b = bh >> 3, hh = bh & 7;
        float lb[8], om[8], on8[8];
#pragma unroll
        for (int i = 0; i < 8; ++i) { lb[i] = lbv[hh * 128 + d0 + i]; om[i] = 1.0f - lb[i]; on8[i] = onorm[eg * 8 + i]; }
        f32x16 S[2];
#pragma unroll
        for (int i = 0; i < 2; ++i)
#pragma unroll
            for (int j = 0; j < 16; ++j) S[i][j] = 0.f;
        const bf16* prow = PROJ + (size_t)(b * SEQ + pt) * HG_IN + hh * 128 + d0;
        const bf16* grow = PROJ + (size_t)(b * SEQ + et) * HG_IN + 3072 + hh * 128 + eg * 8;
        bf16* orow = AO + (size_t)(b * SEQ + et) * DM + hh * 128 + eg * 8;
        v4u nq = *(const v4u*)prow, nz = *(const v4u*)(prow + 1024), nv = *(const v4u*)(prow + 2048), ng = *(const v4u*)grow;
#pragma unroll 1
        for (int c = 0; c < 64; ++c) {
            float q8[8], z8[8], g8[8]; unpack8(nq, q8); unpack8(nz, z8); unpack8(ng, g8); const v4u vraw = nv;
            if (c < 63) { const size_t o = (size_t)(c + 1) * 32 * HG_IN; nq = *(const v4u*)(prow + o); nz = *(const v4u*)(prow + o + 1024); nv = *(const v4u*)(prow + o + 2048); ng = *(const v4u*)(grow + o); }
            float bb[8], k8[8];
#pragma unroll
            for (int i = 0; i < 8; ++i) { const float sg = __builtin_amdgcn_rcpf(1.0f + __builtin_amdgcn_exp2f(-z8[i] * LOG2E)); bb[i] = __builtin_amdgcn_logf(lb[i] + om[i] * sg); k8[i] = om[i] - om[i] * sg; }
            scan32x8(bb);
            float qh[8], kh[8], qb[8];
            float r8[8];
#pragma unroll
            for (int i = 0; i < 8; ++i) r8[i] = __shfl(bb[i], 15 + 32 * h);
#pragma unroll
            for (int i = 0; i < 8; ++i) { const float r = r8[i]; const float fq = __builtin_amdgcn_exp2f(bb[i] - r);
                qh[i] = q8[i] * fq; kh[i] = k8[i] * fminf(__builtin_amdgcn_rcpf(fq), 1.2676506e30f);
                const float eb = __builtin_amdgcn_exp2f(bb[i]);
                qb[i] = q8[i] * eb;
                if (pt == 31) { DEC[128 + d0 + i] = eb; DEC[256 + d0 + i] = fq; } }
            { v4u t; t.x = cvtpk(qh[0], qh[1]); t.y = cvtpk(qh[2], qh[3]); t.z = cvtpk(qh[4], qh[5]); t.w = cvtpk(qh[6], qh[7]); *(LAS v4u*)(QI + wr) = t;
              t.x = cvtpk(qb[0], qb[1]); t.y = cvtpk(qb[2], qb[3]); t.z = cvtpk(qb[4], qb[5]); t.w = cvtpk(qb[6], qb[7]); *(LAS v4u*)(QB + wr) = t;
              t.x = cvtpk(kh[0], kh[1]); t.y = cvtpk(kh[2], kh[3]); t.z = cvtpk(kh[4], kh[5]); t.w = cvtpk(kh[6], kh[7]); *(LAS v4u*)(KI + wr) = t; *(LAS v4u*)(VI + wr) = vraw; }
            WG_BAR_LDS();
            f32x16 X;
#pragma unroll
            for (int j = 0; j < 16; ++j) X[j] = 0.f;
#pragma unroll
            for (int kd = 0; kd < 8; ++kd) X = MFMA32(IMGW_ROW_READ(KI, L, kd), IMGW_ROW_READ(QI, L, kd), X);
#pragma unroll
            for (int j = 0; j < 16; ++j) { const int s = (j & 3) + 8 * (j >> 2) + 4 * h; X[j] = (s <= r32) ? X[j] : 0.f; }
            f32x16 o; const f32x16 zero16 = {0.f, 0.f, 0.f, 0.f, 0.f, 0.f, 0.f, 0.f, 0.f, 0.f, 0.f, 0.f, 0.f, 0.f, 0.f, 0.f};
            { bf16x8 vf; if (dh == 0) { IMGW_TR_FRAG_ACC(vf, VI, L, 0, es); o = MFMA32(pack_acc(X, 0), vf, zero16); } else { IMGW_TR_FRAG_ACC(vf, VI, L, 16, es); o = MFMA32(pack_acc(X, 1), vf, zero16); } }
#pragma unroll
            for (int i = 0; i < 2; ++i) { bf16x8 af;
                if (dh == 0) { IMGW_ROW_FRAG_ACC(af, QB, L, i, 0); o = MFMA32(af, pack_acc(S[i], 0), o); IMGW_ROW_FRAG_ACC(af, QB, L, i, 1); o = MFMA32(af, pack_acc(S[i], 1), o); }
                else { IMGW_ROW_FRAG_ACC(af, QB, L, 2 + i, 0); o = MFMA32(af, pack_acc(S[i], 0), o); IMGW_ROW_FRAG_ACC(af, QB, L, 2 + i, 1); o = MFMA32(af, pack_acc(S[i], 1), o); } }
#pragma unroll
            for (int j = 0; j < 16; ++j) { const int t = (j & 3) + 8 * (j >> 2) + 4 * h; OP[(dh * 32 + t) * HG_OPS + 32 * es + r32] = o[j]; }
#pragma unroll
            for (int i = 0; i < 2; ++i) { const int db = 2 * dh + i; f32x16 T;
                bf16x8 af, bf;
                if (dh == 0) { IMGW_TR_FRAG_NAT(af, KI, L, 0, i); IMGW_TR_FRAG_NAT(bf, VI, L, 0, es); T = MFMA32(af, bf, zero16); IMGW_TR_FRAG_NAT(af, KI, L, 16, i); IMGW_TR_FRAG_NAT(bf, VI, L, 16, es); T = MFMA32(af, bf, T); }
                else { IMGW_TR_FRAG_NAT(af, KI, L, 0, 2 + i); IMGW_TR_FRAG_NAT(bf, VI, L, 0, es); T = MFMA32(af, bf, zero16); IMGW_TR_FRAG_NAT(af, KI, L, 16, 2 + i); IMGW_TR_FRAG_NAT(bf, VI, L, 16, es); T = MFMA32(af, bf, T); }
#pragma unroll
                for (int g = 0; g < 4; ++g) { const f32x4 d1 = *(const LAS f32x4*)(DEC + 128 + 32 * db + 8 * g + 4 * h), d2 = *(const LAS f32x4*)(DEC + 256 + 32 * db + 8 * g + 4 * h);
#pragma unroll
                    for (int j = 0; j < 4; ++j) { const float s1 = S[i][4 * g + j] * d1[j]; S[i][4 * g + j] = __builtin_fmaf(T[4 * g + j], d2[j], s1); } } }
            WG_BAR_LDS();
            { const f32x4 a0 = *(const LAS f32x4*)(OP + et * HG_OPS + 8 * eg), a1 = *(const LAS f32x4*)(OP + et * HG_OPS + 8 * eg + 4), b0 = *(const LAS f32x4*)(OP + (32 + et) * HG_OPS + 8 * eg), b1 = *(const LAS f32x4*)(OP + (32 + et) * HG_OPS + 8 * eg + 4);
              float ov[8] = {a0[0] + b0[0], a0[1] + b0[1], a0[2] + b0[2], a0[3] + b0[3], a1[0] + b1[0], a1[1] + b1[1], a1[2] + b1[2], a1[3] + b1[3]};
              float ss = ((ov[0] * ov[0] + ov[1] * ov[1]) + (ov[2] * ov[2] + ov[3] * ov[3])) + ((ov[4] * ov[4] + ov[5] * ov[5]) + (ov[6] * ov[6] + ov[7] * ov[7]));
              ss += __shfl_xor(ss, 1); ss += __shfl_xor(ss, 2); ss += __shfl_xor(ss, 4); ss += __shfl_xor(ss, 8);
              const float rr = __builtin_amdgcn_rsqf(ss * (1.0f / 128) + EPS);
#pragma unroll
              for (int i = 0; i < 8; ++i) ov[i] = ov[i] * rr * on8[i] * (g8[i] * __builtin_amdgcn_rcpf(1.0f + __builtin_amdgcn_exp2f(-g8[i] * LOG2E)));
              v4u t; t.x = cvtpk(ov[0], ov[1]); t.y = cvtpk(ov[2], ov[3]); t.z = cvtpk(ov[4], ov[5]); t.w = cvtpk(ov[6], ov[7]);
              *(v4u*)(orow + (size_t)c * 32 * DM) = t; }
        }
    }
    WG_BAR();
}
__device__ __forceinline__ void swa_mfma(const Frame& F0, const bf16* PROJ, bf16* AO, const f32x2* ROPE, const float* qnorm, const float* knorm, const float* sinks) {
    Frame F = fresh(F0);
    const int lane = F.lane, w = F.wave, r32 = lane & 31, h = lane >> 5, g = w >> 1;
    const ImgLane L = img_lane(lane, F.tid);
    LAS unsigned char* const KI = F.lds; LAS unsigned char* const VI = F.lds + 32768;
    for (int unit = F.vcu; unit < 1024; unit += F.G) { const int qb = unit & 15, kvh = (unit >> 4) & 1, b = unit >> 5; const int key00 = 128 * (qb - 1);
#pragma unroll
        for (int i = 0; i < 2; ++i) { const int id = F.tid + 512 * i, kr = id >> 2, c = id & 3, key = key00 + kr; const bool kv = key >= 0; const size_t tokk = (size_t)b * SEQ + (kv ? key : 0);
            const bf16* p = PROJ + tokk * AB_IN + 512 + kvh * 64 + 8 * c; v4u a = *(const v4u*)p, bq = *(const v4u*)(p + 32);
            float x1[8], x2[8]; unpack8(a, x1); unpack8(bq, x2); float ss = 0.f;
#pragma unroll
            for (int j = 0; j < 8; ++j) ss += x1[j] * x1[j] + x2[j] * x2[j];
            ss += __shfl_xor(ss, 1); ss += __shfl_xor(ss, 2);
            const float r = kv ? 1.0f / sqrtf(ss * (1.0f / 64) + EPS) : 0.f; const f32x2* tb = ROPE + tokk * 32 + 8 * c;
#pragma unroll
            for (int j = 0; j < 8; ++j) { const f32x2 cs = tb[j]; const float y1 = x1[j] * r * knorm[8 * c + j], y2 = x2[j] * r * knorm[32 + 8 * c + j]; x1[j] = y1 * cs.x - y2 * cs.y; x2[j] = y2 * cs.x + y1 * cs.y; }
            a.x = cvtpk(x1[0], x1[1]); a.y = cvtpk(x1[2], x1[3]); a.z = cvtpk(x1[4], x1[5]); a.w = cvtpk(x1[6], x1[7]); bq.x = cvtpk(x2[0], x2[1]); bq.y = cvtpk(x2[2], x2[3]); bq.z = cvtpk(x2[4], x2[5]); bq.w = cvtpk(x2[6], x2[7]);
            *(LAS v4u*)(KI + img_off(kr, c, 1024)) = a; *(LAS v4u*)(KI + img_off(kr, c + 4, 1024)) = bq; }
#pragma unroll
        for (int i = 0; i < 4; ++i) { const int key = key00 + (F.tid >> 3) + 64 * i; v4u v = (v4u){0u, 0u, 0u, 0u};
            if (key >= 0) v = *(const v4u*)(PROJ + ((size_t)b * SEQ + key) * AB_IN + 640 + kvh * 64 + 8 * (F.tid & 7));
            *(LAS v4u*)(VI + L.wr + 8192 * i) = v; }
        WG_BAR_LDS();
        const int hq = kvh * 4 + g; const float sink2 = sinks[hq] * LOG2E;
#pragma unroll 1
        for (int sbi = 0; sbi < 2; ++sbi) { const int sb = (w & 1) * 2 + sbi, t = 128 * qb + 32 * sb + r32; const size_t tok = (size_t)b * SEQ + t;
            bf16x8 qf[4];
            { const bf16* qp = PROJ + tok * AB_IN + hq * 64 + 8 * h; float x[4][8]; float ss = 0.f;
#pragma unroll
              for (int s = 0; s < 4; ++s) { unpack8(*(const v4u*)(qp + 16 * s), x[s]);
#pragma unroll
                  for (int j = 0; j < 8; ++j) ss += x[s][j] * x[s][j]; }
              ss += __shfl_xor(ss, 32); const float r = (0.125f * LOG2E) / sqrtf(ss * (1.0f / 64) + EPS); const f32x2* tb = ROPE + tok * 32 + 8 * h;
#pragma unroll
              for (int s = 0; s < 2; ++s)
#pragma unroll
                  for (int j = 0; j < 8; ++j) { const f32x2 cs = tb[16 * s + j]; const float y1 = x[s][j] * r * qnorm[16 * s + 8 * h + j], y2 = x[s + 2][j] * r * qnorm[32 + 16 * s + 8 * h + j];
                      x[s][j] = y1 * cs.x - y2 * cs.y; x[s + 2][j] = y2 * cs.x + y1 * cs.y; }
#pragma unroll
              for (int s = 0; s < 4; ++s) { v4u t4; t4.x = cvtpk(x[s][0], x[s][1]); t4.y = cvtpk(x[s][2], x[s][3]); t4.z = cvtpk(x[s][4], x[s][5]); t4.w = cvtpk(x[s][6], x[s][7]); asm volatile("s_nop 1" : "+v"(t4)); qf[s] = __builtin_bit_cast(bf16x8, t4); } }
            f32x16 acc[5]; float mx = sink2;
            const LAS unsigned char* kimg = KI + 4096 * sb; const LAS unsigned char* vimg = VI + 4096 * sb;
#pragma unroll
            for (int j = 0; j < 5; ++j) {
#pragma unroll
                for (int i = 0; i < 16; ++i) acc[j][i] = 0.f;
#pragma unroll
                for (int s = 0; s < 4; ++s) acc[j] = MFMA32(IMG_ROW_READ(kimg, L, j, s), qf[s], acc[j]);
                int rr = r32; asm volatile("" : "+v"(rr)); const bool blk_ok = (key00 + 32 * (sb + j)) >= 0;
#pragma unroll
                for (int i = 0; i < 16; ++i) { const int kap = (i & 3) + 8 * (i >> 2) + 4 * h; const bool valid = blk_ok && (j == 0 ? kap > rr : (j == 4 ? kap <= rr : true));
                    const float v = valid ? acc[j][i] : -3.0e38f; acc[j][i] = v; mx = fmaxf(mx, v); } }
            mx = fmaxf(mx, __shfl_xor(mx, 32)); float l = 0.f;
#pragma unroll
            for (int j = 0; j < 5; ++j)
#pragma unroll
                for (int i = 0; i < 16; ++i) { const float p = __builtin_amdgcn_exp2f(acc[j][i] - mx); acc[j][i] = p; l += p; }
            l += __shfl_xor(l, 32); l += __builtin_amdgcn_exp2f(sink2 - mx); const float linv = 1.0f / l;
            f32x16 o[2];
#pragma unroll
            for (int c = 0; c < 2; ++c) {
#pragma unroll
                for (int i = 0; i < 16; ++i) o[c][i] = 0.f;
#pragma unroll
                for (int j = 0; j < 5; ++j)
#pragma unroll
                    for (int ks = 0; ks < 2; ++ks) { bf16x8 vf; IMG_TR_FRAG_ACC(vf, vimg, L, 32 * j + 16 * ks, c); o[c] = MFMA32(vf, pack_acc(acc[j], ks), o[c]); } }
            bf16* op = AO + tok * DM + hq * 64 + 4 * h;
#pragma unroll
            for (int c = 0; c < 2; ++c)
#pragma unroll
                for (int gg = 0; gg < 4; ++gg) { v2u wv; wv.x = cvtpk(o[c][4 * gg] * linv, o[c][4 * gg + 1] * linv); wv.y = cvtpk(o[c][4 * gg + 2] * linv, o[c][4 * gg + 3] * linv); *(v2u*)(op + 32 * c + 8 * gg) = wv; }
        }
        WG_BAR_LDS();
    }
    WG_BAR();
}
struct Args { const void* in[25]; float* out; unsigned char* ws; };
#if defined(__HIP_DEVICE_COMPILE__)
#define NO_PK_F32 __attribute__((target("no-packed-fp32-ops")))
#else
#define NO_PK_F32
#endif
__global__ void __launch_bounds__(NWAVES * 64, 2) NO_PK_F32 trunk_fwd(Args args) {
    extern __shared__ __attribute__((aligned(16))) unsigned char lds[];
    Frame F;
    F.lds = (LAS unsigned char*)lds; F.MISC = (volatile LAS unsigned*)(F.lds + MISC_OFF);
    F.tid = 0; F.lane = 0; F.gtid = 0; F.gw = 0; F.wave = __builtin_amdgcn_readfirstlane(threadIdx.x >> 6);
    F.G = gridDim.x; { const int bx = blockIdx.x; F.vcu = (F.G % 8 == 0) ? (bx % 8) * (F.G / 8) + bx / 8 : bx; }
    F.NGW = F.G * NWAVES; F.NT = F.G * NWAVES * 64;
    F.ctl = (gu32*)(args.ws + WS_CTL);
    for (int u = threadIdx.x; u < (LDS_BYTES - LDSCTL_OFF) / 4; u += NWAVES * 64) ((LAS unsigned*)(F.lds + LDSCTL_OFF))[u] = 0u;
    asm volatile("s_waitcnt lgkmcnt(0)\n\ts_barrier" ::: "memory");
    XcdBarrier bar = xcd_barrier_post((unsigned*)(F.ctl + CW_BAR), F.MISC + 8);
#define GRID_BAR() xcd_barrier(bar)
    typedef pg8::EpiScaleBf16 ES; typedef pg8::EpiRes ER; typedef pg8::EpiConvGlu EC;
#ifndef REP_G
#define REP_G 1
#endif
#ifndef REP_M
#define REP_M 1
#endif
#ifndef REP_X
#define REP_X 1
#endif
#ifndef REP_H
#define REP_H 1
#endif
#ifndef REP_W
#define REP_W 1
#endif
#ifndef REP_R
#define REP_R 1
#endif
#ifndef REP_SB
#define REP_SB 1
#endif
#ifndef REP_P
#define REP_P 1
#endif
#ifndef REP_C
#define REP_C 1
#endif
#define REPLOOP(n) _Pragma("unroll 1") for (int rep_ = 0; rep_ < (n); ++rep_)
#define RS_LDS ((LAS float*)(F.lds + RING_BYTES + 1024))
#define opq_bx() ({ int bx_ = blockIdx.x; asm volatile("" : "+s"(bx_)); bx_; })
#define opq_g() ({ int g_ = gridDim.x; asm volatile("" : "+s"(g_)); g_; })

#ifndef NO_PRO
    REPLOOP(REP_P) p0_prologue(F);
#endif
    GRID_BAR();
#define WS_BF(off) ((bf16*)(WSP() + (off)))
#define WS_F32(off) ((float*)(WSP() + (off)))
#pragma unroll 1
    for (int l = 0; l < 4; ++l) {
        const int par = l & 1, e = l >> 1;
        { const int N1 = par ? HG_IN : AB_IN; const bf16* Wt = WS_BF(WS_W) + (par ? W_HGIN + (size_t)e * DM * HG_IN : W_ABIN + (size_t)e * DM * AB_IN);
          pg8::Gemm g{WS_BF(WS_XB), Wt, M, N1, DM}; pg8::StaticOrder S; S.init(M, N1, opq_g(), opq_bx()); ES E{WS_BF(WS_BIG), N1, WS_F32(WS_ROWSQ), RS_LDS, par ? nullptr : WS_BF(WS_HM), 5, (size_t)M * 512};
          REPLOOP(REP_G) pg8::gemm_phase<ES, pg8::StaticOrder, true, true>(F.lds, g, S, E); }
        GRID_BAR();
        if (!par) {
#ifdef NAIVE_SWA
            swa_kprep(F, WS_BF(WS_BIG), (const f32x2*)WS_F32(WS_ROPE), INF(I_SWA_K_NORM) + e * 64);
            GRID_BAR();
            swa_naive(F, WS_BF(WS_BIG), WS_BF(WS_AO), (const f32x2*)WS_F32(WS_ROPE), INF(I_SWA_Q_NORM) + e * 64, INF(I_SWA_SINKS) + e * 8);
#else
            REPLOOP(REP_W) swa_mfma(F, WS_BF(WS_BIG), WS_BF(WS_AO), (const f32x2*)WS_F32(WS_ROPE), INF(I_SWA_Q_NORM) + e * 64, INF(I_SWA_K_NORM) + e * 64, INF(I_SWA_SINKS) + e * 8);
#endif
#ifdef NAIVE_SB
            sb_naive(F, WS_BF(WS_BIG), WS_BF(WS_AO));
#else
            REPLOOP(REP_SB) sb_mfma(F, WS_BF(WS_BIG), WS_BF(WS_HM), WS_BF(WS_AO));
#endif
        } else {
#ifdef NAIVE_HGRN
            hgrn_naive(F, WS_BF(WS_BIG), WS_BF(WS_AO), WS_F32(WS_OSQ), WS_F32(WS_LBV) + e * DM);
            GRID_BAR();
            hgrn_post(F, WS_BF(WS_BIG), WS_BF(WS_AO), WS_F32(WS_OSQ), INF(I_HGRN_O_NORM) + e * 128);
#else
            REPLOOP(REP_H) hgrn_mfma(F, WS_BF(WS_BIG), WS_BF(WS_AO), WS_F32(WS_LBV) + e * DM, INF(I_HGRN_O_NORM) + e * 128);
#endif
        }
        GRID_BAR();
        { const bf16* Wt = WS_BF(WS_W) + (par ? W_HGOUT : W_ABOUT) + (size_t)e * DM * DM;
          pg8::Gemm g{WS_BF(WS_AO), Wt, M, DM, DM}; pg8::StaticOrder S; S.init(M, DM, opq_g(), opq_bx()); ER E{nullptr, WS_BF(WS_XB), WS_F32(WS_ROWSQ), false, WS_BF(WS_XB)};
#if REP_R > 1
          { ER Ed{nullptr, WS_BF(WS_XB), WS_F32(WS_OSQ), false, WS_BF(WS_BIG)}; pg8::gemm_phase<ER, pg8::StaticOrder, true, true>(F.lds, g, S, Ed); }
#endif
          pg8::gemm_phase<ER, pg8::StaticOrder, true, true>(F.lds, g, S, E); }
        GRID_BAR();
        { pg8::Gemm g{WS_BF(WS_XB), WS_BF(WS_W) + W_XQ + (size_t)l * DM * DM, M, DM, DM}; pg8::StaticOrder S; S.init(M, DM, opq_g(), opq_bx()); ES E{WS_BF(WS_BIG), DM, WS_F32(WS_ROWSQ), RS_LDS, nullptr, 0, 0};
          REPLOOP(REP_G) pg8::gemm_phase<ES, pg8::StaticOrder, true, true>(F.lds, g, S, E); }
        { pg8::Gemm g{WS_BF(WS_MEMB), WS_BF(WS_W) + W_XKV + (size_t)l * DM * 2 * DM, MM, 2 * DM, DM}; pg8::StaticOrder S; S.init(MM, 2 * DM, opq_g(), opq_bx()); pg8::EpiKV E{WS_BF(WS_KV), 2 * DM, INF(I_XA_Q_NORM) + l * 256, INF(I_XA_K_NORM) + l * 256, RS_LDS};
          REPLOOP(REP_G) pg8::gemm_phase<pg8::EpiKV, pg8::StaticOrder, true, true>(F.lds, g, S, E); }
        GRID_BAR();
#ifdef NAIVE_CROSS
        cross_naive(F, WS_BF(WS_BIG), WS_BF(WS_KV), WS_BF(WS_AO), INF(I_XA_Q_NORM) + l * 256, INF(I_XA_K_NORM) + l * 256);
#else
        REPLOOP(REP_X) cross_mfma(F, WS_BF(WS_BIG), WS_BF(WS_KV), WS_BF(WS_AO), INF(I_XA_Q_NORM) + l * 256, INF(I_XA_K_NORM) + l * 256);
#endif
        GRID_BAR();
        { pg8::Gemm g{WS_BF(WS_AO), WS_BF(WS_W) + W_XO + (size_t)l * DM * DM, M, DM, DM}; pg8::StaticOrder S; S.init(M, DM, opq_g(), opq_bx()); ER E{nullptr, WS_BF(WS_XB), WS_F32(WS_ROWSQ), false, WS_BF(WS_XB)};
#if REP_R > 1
          { ER Ed{nullptr, WS_BF(WS_XB), WS_F32(WS_OSQ), false, WS_BF(WS_BIG)}; pg8::gemm_phase<ER, pg8::StaticOrder, true, true>(F.lds, g, S, Ed); }
#endif
          pg8::gemm_phase<ER, pg8::StaticOrder, true, true>(F.lds, g, S, E); }
        GRID_BAR();
        { pg8::Gemm g{WS_BF(WS_XB), WS_BF(WS_W) + W_UP + (size_t)l * DM * UPN, M, UPN, DM}; pg8::StaticOrder S; S.init(M, UPN, opq_g(), opq_bx());
          EC E{WS_BF(WS_ACT), WS_F32(WS_ROWSQ), INF(I_FFN_CONV_W) + (size_t)l * 3 * UPN, INF(I_FFN_CONV_B) + (size_t)l * UPN, WS_F32(WS_EDGE), RS_LDS};
          REPLOOP(REP_G) pg8::gemm_phase<EC, pg8::StaticOrder, true, true, true>(F.lds, g, S, E); }
        GRID_BAR();
        ffn_fix(F, WS_F32(WS_EDGE), WS_BF(WS_ACT), INF(I_FFN_CONV_W) + (size_t)l * 3 * UPN, INF(I_FFN_CONV_B) + (size_t)l * UPN);
        GRID_BAR();
        { pg8::Gemm g{WS_BF(WS_ACT), WS_BF(WS_W) + W_DOWN + (size_t)l * DFF * DM, M, DM, DFF}; pg8::StaticOrder S; S.init(M, DM, opq_g(), opq_bx()); ER E{OUTP(), WS_BF(WS_XB), WS_F32(WS_ROWSQ), l == 3, WS_BF(WS_XB)};
#if REP_R > 1
          { ER Ed{nullptr, WS_BF(WS_XB), WS_F32(WS_OSQ), false, WS_BF(WS_AO)}; pg8::gemm_phase<ER, pg8::StaticOrder, true, true>(F.lds, g, S, Ed); }
#endif
          pg8::gemm_phase<ER, pg8::StaticOrder, true, true>(F.lds, g, S, E); }
        GRID_BAR();
    }
}

extern "C" void kernel_launch(void* const* d_in, const int* in_sizes, int n_in, void* d_out, int out_size, void* d_ws, size_t ws_size, hipStream_t stream) {
    static int grid = 0;
    if (grid == 0) {
        if (n_in != 25 || in_sizes[0] != M * DM || out_size != M * DM || ws_size < WS_END) { fprintf(stderr, "kernel_launch: unexpected shapes / workspace (n_in %d, in0 %d, out %d, ws %zu < %zu); nothing launched\n", n_in, n_in > 0 ? in_sizes[0] : -1, out_size, ws_size, (size_t)WS_END); grid = -1; return; }
        int dev = 0, cus = 0, per_cu = 0;
        if (hipGetDevice(&dev) != hipSuccess || hipDeviceGetAttribute(&cus, hipDeviceAttributeMultiprocessorCount, dev) != hipSuccess) { grid = -1; return; }
        if (hipFuncSetAttribute((const void*)trunk_fwd, hipFuncAttributeMaxDynamicSharedMemorySize, LDS_BYTES) != hipSuccess) { fprintf(stderr, "kernel_launch: hipFuncSetAttribute failed\n"); grid = -1; return; }
        if (hipOccupancyMaxActiveBlocksPerMultiprocessor(&per_cu, (const void*)trunk_fwd, NWAVES * 64, LDS_BYTES) != hipSuccess || per_cu < 1) fprintf(stderr, "kernel_launch: note: occupancy query reports %d\n", per_cu);
        (void)hipGetLastError();
        grid = cus;
    }
    if (grid < 0) return;
    if (hipMemsetAsync((char*)d_ws + WS_CTL, 0, CTL_ZERO_BYTES, stream) != hipSuccess) return;
    Args a{};
    for (int i = 0; i < 25; ++i) a.in[i] = d_in[i];
    a.out = (float*)d_out; a.ws = (unsigned char*)d_ws;
    hipLaunchKernelGGL(trunk_fwd, dim3(grid), dim3(NWAVES * 64), LDS_BYTES, stream, a);
}
```
